# Optimizing an MI355X kernel written in HIP

```python
import math
import jax, jax.numpy as jnp
from jax import lax
import numpy as np

D_MODEL = 1024
BATCH = 8
SEQ = 2048
DEPTH = 4

HEAD_DIM = 64
DIL_GROUPS = ((128, 1), (512, 4), (2048, 16))
N_DIL_GROUPS = 3
HEADS_PER_GROUP = 8
DIL_WIDTH = N_DIL_GROUPS * HEADS_PER_GROUP * HEAD_DIM
DIL_OUT = HEADS_PER_GROUP * HEAD_DIM
DIFF_HEADS = D_MODEL // (2 * HEAD_DIM)
DIFF_QK = DIFF_HEADS * 2 * HEAD_DIM
DIFF_V = DIFF_HEADS * 2 * HEAD_DIM
BLK = 128
NUM_BUCKETS = 32
MAX_DISTANCE = 2048
N_BIAS_HEADS = N_DIL_GROUPS * HEADS_PER_GROUP + DIFF_HEADS
IN_WIDTH = 3 * DIL_WIDTH + 2 * DIFF_QK + DIFF_V + 2 * D_MODEL
PEER_HEADS = 8
PEER_DQ = 256
PEER_DK = PEER_DQ // 2
N_KEYS = 128
N_EXPERTS = N_KEYS * N_KEYS
PEER_TOPK = 16
PEER_CHUNK = 128
NORM_EPS = 1e-6
SUBLN_EPS = 1e-5
NEG_INF = -1e30

kernel_name = 'hybrid_dilated_diff_peer_block'


def rmsnorm(x, g, eps=NORM_EPS):
    xf = x.astype(jnp.float32)
    y = xf * lax.rsqrt(jnp.mean(xf * xf, axis=-1, keepdims=True) + eps)
    return (y * g.astype(jnp.float32)).astype(x.dtype)


def t5_bucket(dist):
    max_exact = NUM_BUCKETS // 2
    d = jnp.maximum(dist, 0)
    ratio = jnp.log(jnp.maximum(d, 1).astype(jnp.float32) / max_exact) / math.log(MAX_DISTANCE / max_exact)
    large = jnp.minimum(max_exact + (ratio * (NUM_BUCKETS - max_exact)).astype(jnp.int32), NUM_BUCKETS - 1)
    return jnp.where(d < max_exact, d, large)


def dilated_group(q, k, v, bias_tab, n_back, r):
    b, s, h, dh = q.shape
    L = s // r
    Lp = -(-L // BLK) * BLK
    nb = Lp // BLK

    def strided(a):
        a = a.reshape(b, L, r, h, dh).transpose(0, 2, 1, 3, 4)
        a = jnp.pad(a, ((0, 0), (0, 0), (0, Lp - L), (0, 0), (0, 0)))
        return a.reshape(b, r, nb, BLK, h, dh)

    def with_prev(a):
        prev = jnp.pad(a, ((0, 0), (0, 0), (1, 0), (0, 0), (0, 0), (0, 0)))[:, :, :nb]
        return jnp.concatenate([prev, a], axis=3)

    qs, ks, vs = strided(q), strided(k), strided(v)
    kw, vw = with_prev(ks), with_prev(vs)
    qi = jnp.arange(BLK)[:, None]
    kj = jnp.arange(2 * BLK)[None, :]
    delta = qi + BLK - kj
    blk = jnp.arange(nb)[:, None, None]
    valid = (delta >= 0) & (delta <= n_back) & ((blk > 0) | (kj >= BLK))
    bias = bias_tab[t5_bucket(delta * r)].astype(jnp.float32).transpose(2, 0, 1)
    logits = jnp.einsum('bmnqhd,bmnkhd->bmnhqk', qs, kw).astype(jnp.float32) * (dh ** -0.5) + bias
    logits = jnp.where(valid[:, None], logits, NEG_INF)
    mx = jnp.max(logits, axis=-1, keepdims=True)
    p = jnp.exp(logits - mx)
    den = jnp.sum(p, axis=-1, keepdims=True)
    o = jnp.einsum('bmnhqk,bmnkhd->bmnqhd', p / den, vw.astype(jnp.float32))
    lse = (mx + jnp.log(den))[..., 0].transpose(0, 1, 2, 4, 3)

    def unstrided(a):
        a = a.reshape((b, r, Lp) + a.shape[4:])[:, :, :L]
        a = jnp.swapaxes(a, 1, 2)
        return a.reshape((b, s) + a.shape[3:])

    return unstrided(o), unstrided(lse)


def diff_attention(q, k, v, bias_tab, lam, subln_g, lam_init):
    b, s, h, _, dh = q.shape
    nb = s // BLK
    kpos = jnp.arange(s)
    qblocks = jnp.moveaxis(q.reshape(b, nb, BLK, h, 2, dh), 1, 0)
    vf = v.astype(jnp.float32)

    def one_block(args):
        qb, n = args
        qpos = n * BLK + jnp.arange(BLK)
        dist = qpos[:, None] - kpos[None, :]
        bias = bias_tab[t5_bucket(dist)].astype(jnp.float32).transpose(2, 0, 1)
        logits = jnp.einsum('bqhtd,bkhtd->bthqk', qb, k).astype(jnp.float32) * (dh ** -0.5) + bias
        logits = jnp.where(dist >= 0, logits, NEG_INF)
        att = jax.nn.softmax(logits, axis=-1)
        w = att[:, 0] - lam * att[:, 1]
        return jnp.einsum('bhqk,bkhd->bqhd', w, vf)

    o = lax.map(one_block, (qblocks, jnp.arange(nb)))
    o = jnp.moveaxis(o, 0, 1).reshape(b, s, h, 2 * dh)
    o = rmsnorm(o, subln_g, SUBLN_EPS) * (1.0 - lam_init)
    return o.reshape(b, s, h * 2 * dh).astype(q.dtype)


def token_mixer(h, w_in, w_pa, w_pb, w_o, lq1, lk1, lq2, lk2, subln_g, rel_bias, lam_init):
    b, s, _ = h.shape
    proj = h @ w_in
    sizes = [DIL_WIDTH, DIL_WIDTH, DIL_WIDTH, DIFF_QK, DIFF_QK, DIFF_V, D_MODEL]
    cuts = [int(i) for i in np.cumsum(sizes)]
    qa, ka, va, qb, kb, vb, ga, gb = jnp.split(proj, cuts, axis=-1)
    shp_a = (b, s, N_DIL_GROUPS, HEADS_PER_GROUP, HEAD_DIM)
    qa, ka, va = qa.reshape(shp_a), ka.reshape(shp_a), va.reshape(shp_a)
    outs, lses = [], []
    for g, (window, dil) in enumerate(DIL_GROUPS):
        tab = rel_bias[:, g * HEADS_PER_GROUP:(g + 1) * HEADS_PER_GROUP]
        o, lse = dilated_group(qa[:, :, g], ka[:, :, g], va[:, :, g], tab, window // dil, dil)
        outs.append(o)
        lses.append(lse)
    wts = jax.nn.softmax(jnp.stack(lses, 0), axis=0)
    oa = jnp.sum(wts[..., None] * jnp.stack(outs, 0), axis=0).reshape(b, s, DIL_OUT).astype(h.dtype)
    lam = jnp.exp(jnp.sum(lq1 * lk1)) - jnp.exp(jnp.sum(lq2 * lk2)) + lam_init
    ob = diff_attention(qb.reshape(b, s, DIFF_HEADS, 2, HEAD_DIM), kb.reshape(b, s, DIFF_HEADS, 2, HEAD_DIM),
                        vb.reshape(b, s, DIFF_HEADS, 2 * HEAD_DIM), rel_bias[:, N_DIL_GROUPS * HEADS_PER_GROUP:],
                        lam, subln_g, lam_init)
    merged = jax.nn.sigmoid(ga) * (oa @ w_pa) + jax.nn.sigmoid(gb) * (ob @ w_pb)
    return merged @ w_o


def peer(h, w_q, sub_keys, u_tab, v_tab):
    b, s, d = h.shape
    t = b * s
    xt = h.reshape(t, d)
    q = (xt @ w_q).reshape(t, PEER_HEADS, 2, PEER_DK)
    sc = jnp.einsum('thpd,pkd->thpk', q, sub_keys).astype(jnp.float32)
    top_s, top_i = lax.top_k(sc, PEER_TOPK)
    cand_s = (top_s[:, :, 0, :, None] + top_s[:, :, 1, None, :]).reshape(t, PEER_HEADS, PEER_TOPK * PEER_TOPK)
    cand_id = (top_i[:, :, 0, :, None] * N_KEYS + top_i[:, :, 1, None, :]).reshape(t, PEER_HEADS, PEER_TOPK * PEER_TOPK)
    best_s, best_j = lax.top_k(cand_s, PEER_TOPK)
    ids = jnp.take_along_axis(cand_id, best_j, axis=-1)
    gates = jax.nn.softmax(best_s, axis=-1)
    nc = t // PEER_CHUNK

    def chunk(args):
        xc, idc, gc = args
        u = u_tab[idc]
        act = jax.nn.gelu(jnp.einsum('cd,chkd->chk', xc, u).astype(jnp.float32))
        vv = v_tab[idc]
        return jnp.einsum('chk,chkd->cd', (gc * act).astype(xc.dtype), vv)

    out = lax.map(chunk, (xt.reshape(nc, PEER_CHUNK, d),
                          ids.reshape(nc, PEER_CHUNK, PEER_HEADS, PEER_TOPK),
                          gates.reshape(nc, PEER_CHUNK, PEER_HEADS, PEER_TOPK)))
    return out.reshape(b, s, d)


def setup_inputs(seed: int = 0) -> dict:
    key = jax.random.key(seed)
    ks = jax.random.split(key, 21)
    f32 = jnp.float32

    def nrm(k, shape, std):
        return jax.random.normal(k, shape, f32) * std

    x = nrm(ks[0], (BATCH, SEQ, D_MODEL), 1.0)
    c = nrm(ks[1], (BATCH, D_MODEL), 1.0)
    w_ada = nrm(ks[2], (DEPTH, D_MODEL, 6 * D_MODEL), 0.5 * D_MODEL ** -0.5)
    b_ada = nrm(ks[3], (DEPTH, 6 * D_MODEL), 0.02)
    norm1_g = 1.0 + nrm(ks[4], (DEPTH, D_MODEL), 0.02)
    norm2_g = 1.0 + nrm(ks[5], (DEPTH, D_MODEL), 0.02)
    w_in = nrm(ks[6], (DEPTH, D_MODEL, IN_WIDTH), D_MODEL ** -0.5)
    w_proj_a = nrm(ks[7], (DEPTH, DIL_OUT, D_MODEL), DIL_OUT ** -0.5)
    w_proj_b = nrm(ks[8], (DEPTH, DIFF_V, D_MODEL), DIFF_V ** -0.5)
    w_out = nrm(ks[9], (DEPTH, D_MODEL, D_MODEL), D_MODEL ** -0.5)
    lam_q1 = nrm(ks[10], (DEPTH, HEAD_DIM), 0.1)
    lam_k1 = nrm(ks[11], (DEPTH, HEAD_DIM), 0.1)
    lam_q2 = nrm(ks[12], (DEPTH, HEAD_DIM), 0.1)
    lam_k2 = nrm(ks[13], (DEPTH, HEAD_DIM), 0.1)
    subln_g = 1.0 + nrm(ks[14], (DEPTH, 2 * HEAD_DIM), 0.02)
    rel_bias = nrm(ks[15], (NUM_BUCKETS, N_BIAS_HEADS), 0.5)
    peer_wq = nrm(ks[16], (DEPTH, D_MODEL, PEER_HEADS * PEER_DQ), D_MODEL ** -0.5)
    peer_subkeys = nrm(ks[17], (DEPTH, 2, N_KEYS, PEER_DK), PEER_DK ** -0.5)
    peer_u = nrm(ks[18], (DEPTH, N_EXPERTS, D_MODEL), D_MODEL ** -0.5)
    peer_v = nrm(ks[19], (DEPTH, N_EXPERTS, D_MODEL), PEER_HEADS ** -0.5)
    final_g = 1.0 + nrm(ks[20], (D_MODEL,), 0.02)
    return {'x': x, 'c': c, 'w_ada': w_ada, 'b_ada': b_ada, 'norm1_g': norm1_g, 'norm2_g': norm2_g,
            'w_in': w_in, 'w_proj_a': w_proj_a, 'w_proj_b': w_proj_b, 'w_out': w_out,
            'lam_q1': lam_q1, 'lam_k1': lam_k1, 'lam_q2': lam_q2, 'lam_k2': lam_k2, 'subln_g': subln_g,
            'rel_bias': rel_bias, 'peer_wq': peer_wq, 'peer_subkeys': peer_subkeys,
            'peer_u': peer_u, 'peer_v': peer_v, 'final_g': final_g}


def reference(x, c, w_ada, b_ada, norm1_g, norm2_g, w_in, w_proj_a, w_proj_b, w_out,
              lam_q1, lam_k1, lam_q2, lam_k2, subln_g, rel_bias, peer_wq, peer_subkeys,
              peer_u, peer_v, final_g):
    cond = jax.nn.silu(c)
    for l in range(DEPTH):
        lam_init = 0.8 - 0.6 * math.exp(-0.3 * l)
        mod = (cond @ w_ada[l] + b_ada[l])[:, None, :]
        sh1, sc1, g1, sh2, sc2, g2 = jnp.split(mod, 6, axis=-1)
        h = rmsnorm(x, norm1_g[l]) * (1.0 + sc1) + sh1
        x = x + g1 * token_mixer(h, w_in[l], w_proj_a[l], w_proj_b[l], w_out[l],
                                 lam_q1[l], lam_k1[l], lam_q2[l], lam_k2[l], subln_g[l], rel_bias, lam_init)
        h = rmsnorm(x, norm2_g[l]) * (1.0 + sc2) + sh2
        x = x + g2 * peer(h, peer_wq[l], peer_subkeys[l], peer_u[l], peer_v[l])
    return rmsnorm(x, final_g)
```

```cpp
#include <hip/hip_runtime.h>
#include <hip/hip_bf16.h>
#include <cstdio>
#include <cstdint>
#include <cmath>
#ifndef MK_PER_PHASE
#define MK_PER_PHASE 0
#endif
namespace pg8 {
#define PG8_LAS __attribute__((address_space(3)))
typedef unsigned short bf16_t;
typedef short bf16x8 __attribute__((ext_vector_type(8)));
typedef float f32x4 __attribute__((ext_vector_type(4)));
typedef unsigned u32x4 __attribute__((ext_vector_type(4)));
constexpr int BM = 256, BK = 64, HALF = 128, HTB = HALF * BK * 2  , STAGE_BYTES = 8 * HTB, NXCD = 8, WGM = 8;

__host__ __device__ __forceinline__ int lds_byte(int r, int c) { const int st = (r >> 4) * 2 + (c >> 5), rr = r & 15, cc = c & 31, ob = rr * 64 + cc * 2; return st * 1024 + (ob ^ (((ob >> 9) & 1) << 5)); }
__host__ __device__ __forceinline__ void stage_rc(int b, int& R, int& C) { const int st = b / 1024, sb = b % 1024, swz = sb ^ (((sb >> 9) & 1) << 5); R = (st >> 1) * 16 + swz / 64; C = (st & 1) * 32 + (swz % 64) / 2; }
__host__ __device__ __forceinline__ int perm32(int rho) { const int n = rho >> 4, i = rho & 15; return 8 * (i >> 2) + 4 * n + (i & 3); }

struct Unit { int pm, pn; };
struct Gemm { const bf16_t* A; const bf16_t* Bt; int M, N, K; };

struct StaticOrder {
    int nM, nN, nwg, G, c;
    __host__ __device__ void init(int M, int N, int G_, int c_) { nM = M / BM; nN = N / BM; nwg = nM * nN; G = G_; c = c_; }
    __host__ __device__ bool next(int i, Unit& u) const {
        const long L = (long)i * G + c; if (L >= nwg) return false;
        int wgid = (int)L; { const int q = nwg / NXCD, r = nwg % NXCD, xcd = wgid % NXCD, off = wgid / NXCD; wgid = (xcd < r ? xcd * (q + 1) : r * (q + 1) + (xcd - r) * q) + off; }
        const int nig = WGM * nN, gid = wgid / nig, fm = gid * WGM, gsz = (nM - fm) < WGM ? (nM - fm) : WGM;
        u.pm = fm + ((wgid % nig) % gsz); u.pn = (wgid % nig) / gsz; return true;
    }
    __device__ __forceinline__ void a_ready(const Unit&) const {}
    __device__ __forceinline__ void done(const Unit&) const {}
};

__device__ __forceinline__ unsigned cvt_pk_bf16(float lo, float hi) { unsigned r; asm volatile("v_cvt_pk_bf16_f32 %0, %1, %2" : "=v"(r) : "v"(lo), "v"(hi)); return r; }
typedef float f32x2 __attribute__((ext_vector_type(2)));
__device__ __forceinline__ f32x2 gelu_pk(f32x2 v) {
    const f32x2 av = __builtin_elementwise_abs(v), d = av * 0.2316418882f + 1.0f;
    f32x2 t; t.x = __builtin_amdgcn_rcpf(d.x); t.y = __builtin_amdgcn_rcpf(d.y);
    f32x2 q = t * 0.5307027145f + (-0.7265760135f); q = q * t + 0.7107068705f; q = q * t + (-0.142248368f); q = q * t + 0.127414796f; q = q * t;
    const f32x2 s = (v * v) * (-0.72134752044f);
    f32x2 e; e.x = __builtin_amdgcn_exp2f(s.x); e.y = __builtin_amdgcn_exp2f(s.y);
    const f32x2 m = v * (q * e), r = v - m;
    f32x2 o; o.x = v.x < 0.f ? m.x : r.x; o.y = v.y < 0.f ? m.y : r.y; return o;
}

template <int ACT  > struct EpiBf16 {
    static constexpr bool PERM = true, AFTER_DRAIN = false; static_assert(ACT == 0 || ACT == 1, "EpiBf16: ACT is 0 (none) or 1 (gelu_pk)");
    bf16_t* O; int ldc; const float* bias; int split_cols; size_t split_stride; float scale0;
    __device__ __forceinline__ void operator()(const f32x4 (&acc)[2][2][4][2], const Unit& u, int wr, int wc, int fr, int fq) const {
        const int row0 = u.pm * BM + wr * 64 + fr; int colt = u.pn * BM; bf16_t* base = O;
        float sc = 1.f; if (split_cols) { const int t = colt / split_cols; base += (size_t)t * split_stride; colt -= t * split_cols; if (t == 0) sc = scale0; }
        const int col0 = colt + wc * 32 + 8 * fq, bcol0 = u.pn * BM + wc * 32 + 8 * fq;
        f32x4 bv[2][2];
#pragma unroll
        for (int bj = 0; bj < 2; ++bj)
#pragma unroll
            for (int n = 0; n < 2; ++n) bv[bj][n] = bias ? *(const f32x4*)(bias + bcol0 + bj * HALF + 4 * n) : (f32x4){0.f, 0.f, 0.f, 0.f};
#pragma unroll
        for (int ai = 0; ai < 2; ++ai)
#pragma unroll
            for (int m = 0; m < 4; ++m) { bf16_t* rowp = base + (size_t)(row0 + ai * HALF + m * 16) * ldc + col0;
#pragma unroll
                for (int bj = 0; bj < 2; ++bj) { f32x4 v0 = acc[ai][bj][m][0] + bv[bj][0], v1 = acc[ai][bj][m][1] + bv[bj][1];
                    if (ACT == 1) { f32x2 a = gelu_pk((f32x2){v0[0], v0[1]}), b = gelu_pk((f32x2){v0[2], v0[3]}), c = gelu_pk((f32x2){v1[0], v1[1]}), d = gelu_pk((f32x2){v1[2], v1[3]});
                        v0 = (f32x4){a.x, a.y, b.x, b.y}; v1 = (f32x4){c.x, c.y, d.x, d.y}; }
                    v0 = v0 * sc; v1 = v1 * sc; u32x4 w; w.x = cvt_pk_bf16(v0[0], v0[1]); w.y = cvt_pk_bf16(v0[2], v0[3]); w.z = cvt_pk_bf16(v1[0], v1[1]); w.w = cvt_pk_bf16(v1[2], v1[3]);
                    *(u32x4*)(rowp + bj * HALF) = w; } }
    }
};
typedef unsigned u32x2 __attribute__((ext_vector_type(2)));
__device__ __forceinline__ float bf_lo(unsigned w) { return __uint_as_float(w << 16); }
__device__ __forceinline__ float bf_hi(unsigned w) { return __uint_as_float(w & 0xffff0000u); }
__device__ __forceinline__ float sigmoidf_fast(float v) { return __builtin_amdgcn_rcpf(1.0f + __builtin_amdgcn_exp2f(-1.4426950408889634f * v)); }
struct EpiProj {
    static constexpr bool PERM = true, AFTER_DRAIN = false;
    bf16_t* O; int ldc; float c2;
    __device__ __forceinline__ void operator()(const f32x4 (&acc)[2][2][4][2], const Unit& u, int wr, int wc, int fr, int fq) const {
        const int row0 = u.pm * BM + wr * 64 + fr, col0 = u.pn * BM + wc * 32 + 8 * fq;
        const bool isq = (u.pn < 6) || (u.pn >= 18 && u.pn < 22), isg = (u.pn >= 30);
        const float sc = isq ? c2 : 1.0f;
#pragma unroll
        for (int ai = 0; ai < 2; ++ai)
#pragma unroll
            for (int m = 0; m < 4; ++m) { bf16_t* rowp = O + (size_t)(row0 + ai * HALF + m * 16) * ldc + col0;
#pragma unroll
                for (int bj = 0; bj < 2; ++bj) { f32x4 v0 = acc[ai][bj][m][0], v1 = acc[ai][bj][m][1];
                    if (isg) { v0 = (f32x4){sigmoidf_fast(v0[0]), sigmoidf_fast(v0[1]), sigmoidf_fast(v0[2]), sigmoidf_fast(v0[3])}; v1 = (f32x4){sigmoidf_fast(v1[0]), sigmoidf_fast(v1[1]), sigmoidf_fast(v1[2]), sigmoidf_fast(v1[3])}; }
                    else { v0 = v0 * sc; v1 = v1 * sc; }
                    u32x4 w; w.x = cvt_pk_bf16(v0[0], v0[1]); w.y = cvt_pk_bf16(v0[2], v0[3]); w.z = cvt_pk_bf16(v1[0], v1[1]); w.w = cvt_pk_bf16(v1[2], v1[3]);
                    *(u32x4*)(rowp + bj * HALF) = w; } }
    }
};
struct EpiGateMulF32 {
    static constexpr bool PERM = true, AFTER_DRAIN = false;
    float* T; int ldc; const bf16_t* G; int ldg;
    __device__ __forceinline__ void operator()(const f32x4 (&acc)[2][2][4][2], const Unit& u, int wr, int wc, int fr, int fq) const {
        const int row0 = u.pm * BM + wr * 64 + fr, col0 = u.pn * BM + wc * 32 + 8 * fq;
#pragma unroll
        for (int ai = 0; ai < 2; ++ai)
#pragma unroll
            for (int m = 0; m < 4; ++m) { const size_t row = (size_t)(row0 + ai * HALF + m * 16);
#pragma unroll
                for (int bj = 0; bj < 2; ++bj) { const int c = col0 + bj * HALF; const u32x4 g = *(const u32x4*)(G + row * ldg + c);
                    f32x4 v0 = acc[ai][bj][m][0], v1 = acc[ai][bj][m][1];
                    v0 = v0 * (f32x4){bf_lo(g.x), bf_hi(g.x), bf_lo(g.y), bf_hi(g.y)}; v1 = v1 * (f32x4){bf_lo(g.z), bf_hi(g.z), bf_lo(g.w), bf_hi(g.w)};
                    *(f32x4*)(T + row * ldc + c) = v0; *(f32x4*)(T + row * ldc + c + 4) = v1; } }
    }
};
struct EpiGateAddBf16 {
    static constexpr bool PERM = true, AFTER_DRAIN = false;
    bf16_t* O; const float* T; int ldc; const bf16_t* G; int ldg;
    __device__ __forceinline__ void operator()(const f32x4 (&acc)[2][2][4][2], const Unit& u, int wr, int wc, int fr, int fq) const {
        const int row0 = u.pm * BM + wr * 64 + fr, col0 = u.pn * BM + wc * 32 + 8 * fq;
#pragma unroll
        for (int ai = 0; ai < 2; ++ai)
#pragma unroll
            for (int m = 0; m < 4; ++m) { const size_t row = (size_t)(row0 + ai * HALF + m * 16);
#pragma unroll
                for (int bj = 0; bj < 2; ++bj) { const int c = col0 + bj * HALF; const u32x4 g = *(const u32x4*)(G + row * ldg + c);
                    const f32x4 t0 = *(const f32x4*)(T + row * ldc + c), t1 = *(const f32x4*)(T + row * ldc + c + 4);
                    f32x4 v0 = acc[ai][bj][m][0], v1 = acc[ai][bj][m][1];
                    v0 = t0 + v0 * (f32x4){bf_lo(g.x), bf_hi(g.x), bf_lo(g.y), bf_hi(g.y)}; v1 = t1 + v1 * (f32x4){bf_lo(g.z), bf_hi(g.z), bf_lo(g.w), bf_hi(g.w)};
                    u32x4 w; w.x = cvt_pk_bf16(v0[0], v0[1]); w.y = cvt_pk_bf16(v0[2], v0[3]); w.z = cvt_pk_bf16(v1[0], v1[1]); w.w = cvt_pk_bf16(v1[2], v1[3]);
                    *(u32x4*)(O + row * ldc + c) = w; } }
    }
};
struct EpiResid {
    static constexpr bool PERM = true, AFTER_DRAIN = false;
    float* X; int ldc; const float* gvec; int gstride; int rows_per_batch;
    __device__ __forceinline__ void operator()(const f32x4 (&acc)[2][2][4][2], const Unit& u, int wr, int wc, int fr, int fq) const {
        const int row0 = u.pm * BM + wr * 64 + fr, col0 = u.pn * BM + wc * 32 + 8 * fq;
        const float* gv = gvec + (size_t)((u.pm * BM) / rows_per_batch) * gstride;
        f32x4 g0[2], g1[2];
#pragma unroll
        for (int bj = 0; bj < 2; ++bj) { g0[bj] = *(const f32x4*)(gv + col0 + bj * HALF); g1[bj] = *(const f32x4*)(gv + col0 + bj * HALF + 4); }
#pragma unroll
        for (int ai = 0; ai < 2; ++ai)
#pragma unroll
            for (int m = 0; m < 4; ++m) { const size_t row = (size_t)(row0 + ai * HALF + m * 16);
#pragma unroll
                for (int bj = 0; bj < 2; ++bj) { float* p = X + row * ldc + col0 + bj * HALF;
                    const f32x4 x0 = *(const f32x4*)p, x1 = *(const f32x4*)(p + 4);
                    #ifdef DBG_SKIP_MIX
                    *(f32x4*)p = x0; *(f32x4*)(p + 4) = x1; } }
#else
                    *(f32x4*)p = x0 + g0[bj] * acc[ai][bj][m][0]; *(f32x4*)(p + 4) = x1 + g1[bj] * acc[ai][bj][m][1]; } }
#endif
    }
};
template <class Epi, class Sched, bool ALIGN_EPI = false, bool SP2 = false>
__device__ __forceinline__ void gemm_phase(PG8_LAS unsigned char* lds, const Gemm g, const Sched& S, const Epi& E) {
    int tid_ = threadIdx.x; asm volatile("" : "+v"(tid_));
    const int tid = tid_, wid = __builtin_amdgcn_readfirstlane(tid >> 6), lane = tid & 63, wr = wid >> 2, wc = wid & 3, fr = lane & 15, fq = lane >> 4;
    const int K = g.K, nt = K / BK;
    unsigned voffA[2], voffB[2];
#pragma unroll
    for (int i = 0; i < 2; ++i) { int R, C; stage_rc(tid * 16 + i * 8192, R, C); const int Rb = Epi::PERM ? ((R & ~31) + perm32(R & 31)) : R;
        voffA[i] = (unsigned)(R * K + C) * 2u; voffB[i] = (unsigned)(Rb * K + C) * 2u; }
    const size_t kstep = (size_t)(BK * 2);
    const size_t hstep = (size_t)HALF * K * 2;
    const size_t tstep = 2 * hstep;
    const unsigned ldsw = (unsigned)wid * 1024u;
    const int aoff = lds_byte(wr * 64 + fr, fq * 8), boff = lds_byte(wc * 32 + fr, fq * 8);
#define PG8_SA(b, h) (((b) * 2 + (h)) * HTB)
#define PG8_SB(b, h) ((4 + (b) * 2 + (h)) * HTB)
#define PG8_STAGE(bufoff, gbase, voff) do { _Pragma("unroll") for (int _i = 0; _i < 2; ++_i) \
        __builtin_amdgcn_global_load_lds((const unsigned*)((const char*)(gbase) + (voff)[_i]), (PG8_LAS unsigned*)(lds + (bufoff) + ldsw + _i * 8192), 16, 0, 0); } while (0)
#define PG8_LDA(dst, b, h) do { _Pragma("unroll") for (int m = 0; m < 4; ++m) _Pragma("unroll") for (int k = 0; k < 2; ++k) dst[m][k] = *(const PG8_LAS bf16x8*)(lds + PG8_SA(b, h) + aoff + m * 2048 + k * 1024); } while (0)
#define PG8_LDB(dst, b, h) do { _Pragma("unroll") for (int n = 0; n < 2; ++n) _Pragma("unroll") for (int k = 0; k < 2; ++k) dst[n][k] = *(const PG8_LAS bf16x8*)(lds + PG8_SB(b, h) + boff + n * 2048 + k * 1024); } while (0)
#define PG8_MMA(ai, bj, At, Bt) do { __builtin_amdgcn_s_setprio(1); _Pragma("unroll") for (int m = 0; m < 4; ++m) _Pragma("unroll") for (int n = 0; n < 2; ++n) _Pragma("unroll") for (int k = 0; k < 2; ++k) \
        acc[ai][bj][m][n] = __builtin_amdgcn_mfma_f32_16x16x32_bf16(Bt[n][k], At[m][k], acc[ai][bj][m][n], 0, 0, 0); __builtin_amdgcn_s_setprio(0); } while (0)
#define PG8_WAIT_V(n) asm volatile("s_waitcnt vmcnt(" #n ")" ::: "memory")
#define PG8_WAIT_L(n) asm volatile("s_waitcnt lgkmcnt(" #n ")" ::: "memory")
#define PG8_BAR __builtin_amdgcn_s_barrier()
#define PG8_SCHED __builtin_amdgcn_sched_barrier(0)
    Unit cur, nxt; int ui = 0;
    if (!S.next(0, cur)) return;
    f32x4 acc[2][2][4][2];
#pragma unroll
    for (int a = 0; a < 2; ++a)
#pragma unroll
        for (int b = 0; b < 2; ++b)
#pragma unroll
            for (int m = 0; m < 4; ++m)
#pragma unroll
                for (int n = 0; n < 2; ++n) acc[a][b][m][n] = (f32x4){0.f, 0.f, 0.f, 0.f};
    bf16x8 At[4][2], B0[2][2], B1[2][2];
    const char* cA = (const char*)g.A + (size_t)cur.pm * tstep; const char* cB = (const char*)g.Bt + (size_t)cur.pn * tstep;
    S.a_ready(cur);
    if constexpr (SP2) {
        PG8_STAGE(PG8_SB(0, 0), cB, voffB); PG8_STAGE(PG8_SB(0, 1), cB + hstep, voffB); PG8_STAGE(PG8_SA(0, 0), cA, voffA); PG8_STAGE(PG8_SA(0, 1), cA + hstep, voffA);
        if (wr == 1) PG8_BAR;
        PG8_WAIT_V(2); PG8_BAR;
        PG8_STAGE(PG8_SB(1, 0), cB + kstep, voffB); PG8_STAGE(PG8_SA(1, 0), cA + kstep, voffA); PG8_STAGE(PG8_SB(1, 1), cB + hstep + kstep, voffB);
        PG8_WAIT_V(6); PG8_BAR;
    } else {
        PG8_STAGE(PG8_SB(0, 0), cB, voffB); PG8_STAGE(PG8_SA(0, 0), cA, voffA); PG8_STAGE(PG8_SB(0, 1), cB + hstep, voffB); PG8_STAGE(PG8_SA(0, 1), cA + hstep, voffA);
        if (wr == 1) PG8_BAR;
        PG8_WAIT_V(4); PG8_BAR;
        PG8_STAGE(PG8_SB(1, 0), cB + kstep, voffB); PG8_STAGE(PG8_SA(1, 0), cA + kstep, voffA); PG8_STAGE(PG8_SB(1, 1), cB + hstep + kstep, voffB);
        PG8_WAIT_V(6); PG8_BAR;
    }
    for (;;) {
        const bool has_next = S.next(ui + 1, nxt);
        const char* nA = has_next ? (const char*)g.A + (size_t)nxt.pm * tstep : cA; const char* nB = has_next ? (const char*)g.Bt + (size_t)nxt.pn * tstep : cB;
        for (int t = 0; t < nt; t += 2) {
            const bool last = (t == nt - 2);
            const char* a1 = cA + (size_t)(t + 1) * kstep;
            const char* a2 = last ? nA : cA + (size_t)(t + 2) * kstep; const char* b2 = last ? nB : cB + (size_t)(t + 2) * kstep;
            const char* a3 = a2 + kstep; const char* b3 = b2 + kstep;
            if (last && has_next) S.a_ready(nxt);
            if constexpr (SP2) {
            PG8_LDB(B0, 0, 0); PG8_LDB(B1, 0, 1); PG8_SCHED; PG8_LDA(At, 0, 0); PG8_STAGE(PG8_SA(1, 1), a1 + hstep, voffA);
            PG8_WAIT_V(8); PG8_WAIT_L(0); PG8_BAR; PG8_MMA(0, 0, At, B0); PG8_MMA(0, 1, At, B1); PG8_BAR; PG8_SCHED;
            PG8_LDA(At, 0, 1); PG8_STAGE(PG8_SB(0, 0), b2, voffB); PG8_STAGE(PG8_SB(0, 1), b2 + hstep, voffB); PG8_STAGE(PG8_SA(0, 0), a2, voffA);
            PG8_WAIT_V(8); PG8_WAIT_L(0); PG8_BAR; PG8_MMA(1, 0, At, B0); PG8_MMA(1, 1, At, B1); PG8_BAR; PG8_SCHED;
            PG8_LDB(B0, 1, 0); PG8_LDB(B1, 1, 1); PG8_SCHED; PG8_LDA(At, 1, 0); PG8_STAGE(PG8_SA(0, 1), a2 + hstep, voffA);
            PG8_WAIT_V(8); PG8_WAIT_L(0); PG8_BAR; PG8_MMA(0, 0, At, B0); PG8_MMA(0, 1, At, B1); PG8_BAR; PG8_SCHED;
            PG8_LDA(At, 1, 1); PG8_STAGE(PG8_SB(1, 0), b3, voffB); PG8_STAGE(PG8_SB(1, 1), b3 + hstep, voffB); PG8_STAGE(PG8_SA(1, 0), a3, voffA);
            PG8_WAIT_V(8); PG8_WAIT_L(0); PG8_BAR; PG8_MMA(1, 0, At, B0); PG8_MMA(1, 1, At, B1); PG8_BAR; PG8_SCHED;
            } else {
            PG8_LDB(B0, 0, 0); PG8_SCHED; PG8_LDA(At, 0, 0); PG8_STAGE(PG8_SA(1, 1), a1 + hstep, voffA);
            PG8_WAIT_L(8); PG8_BAR; PG8_WAIT_L(0); PG8_MMA(0, 0, At, B0); PG8_BAR; PG8_SCHED;
            PG8_LDB(B1, 0, 1); PG8_STAGE(PG8_SB(0, 0), b2, voffB);
            PG8_BAR; PG8_WAIT_L(0); PG8_MMA(0, 1, At, B1); PG8_BAR;
            PG8_LDA(At, 0, 1); PG8_STAGE(PG8_SA(0, 0), a2, voffA);
            PG8_BAR; PG8_WAIT_L(0); PG8_MMA(1, 0, At, B0); PG8_BAR; PG8_SCHED;
            PG8_STAGE(PG8_SB(0, 1), b2 + hstep, voffB);
            PG8_WAIT_V(6); PG8_BAR; PG8_MMA(1, 1, At, B1); PG8_BAR;
            PG8_LDB(B0, 1, 0); PG8_SCHED; PG8_LDA(At, 1, 0); PG8_STAGE(PG8_SA(0, 1), a2 + hstep, voffA);
            PG8_WAIT_L(8); PG8_BAR; PG8_WAIT_L(0); PG8_MMA(0, 0, At, B0); PG8_BAR; PG8_SCHED;
            PG8_LDB(B1, 1, 1); PG8_STAGE(PG8_SB(1, 0), b3, voffB);
            PG8_BAR; PG8_WAIT_L(0); PG8_MMA(0, 1, At, B1); PG8_BAR;
            PG8_LDA(At, 1, 1); PG8_STAGE(PG8_SA(1, 0), a3, voffA);
            PG8_BAR; PG8_WAIT_L(0); PG8_MMA(1, 0, At, B0); PG8_BAR; PG8_SCHED;
            PG8_STAGE(PG8_SB(1, 1), b3 + hstep, voffB);
            PG8_WAIT_V(6); PG8_BAR; PG8_MMA(1, 1, At, B1); PG8_BAR;
            }
        }
        if constexpr (ALIGN_EPI) { if (wr == 0) PG8_BAR; }
        if constexpr (!Epi::AFTER_DRAIN) { E(acc, cur, wr, wc, fr, fq); S.done(cur); }
        if (!has_next) break;
#pragma unroll
        for (int a = 0; a < 2; ++a)
#pragma unroll
            for (int b = 0; b < 2; ++b)
#pragma unroll
                for (int m = 0; m < 4; ++m)
#pragma unroll
                    for (int n = 0; n < 2; ++n) acc[a][b][m][n] = (f32x4){0.f, 0.f, 0.f, 0.f};
        cur = nxt; cA = nA; cB = nB; ++ui;
        if constexpr (ALIGN_EPI) { if (wr == 1) PG8_BAR; }
    }
    PG8_WAIT_V(0);
    if constexpr (!ALIGN_EPI) { if (wr == 0) PG8_BAR; }
    PG8_BAR;
    if constexpr (Epi::AFTER_DRAIN) { E.fused(acc, cur, wr, wc, fr, fq, lds, wid, lane); S.done(cur); }
#undef PG8_SA
#undef PG8_SB
#undef PG8_STAGE
#undef PG8_LDA
#undef PG8_LDB
#undef PG8_MMA
#undef PG8_WAIT_V
#undef PG8_WAIT_L
#undef PG8_BAR
#undef PG8_SCHED
}
}
#include <hip/hip_bf16.h>
namespace attn_body {
using bf16=__hip_bfloat16;
using bf16x8=__attribute__((ext_vector_type(8)))short;
using s16x4=__attribute__((ext_vector_type(4)))short;
using f32x16=__attribute__((ext_vector_type(16)))float;
using u32x4=__attribute__((ext_vector_type(4)))unsigned;
constexpr int D=64;
constexpr int NW=8,QBLK=32,QB=QBLK*NW,KVBLK=64;
__device__ __forceinline__ int crow(int r,int hi){return (r&3)+8*(r>>2)+4*hi;}
#define SBAR() __builtin_amdgcn_sched_barrier(0)
__device__ __forceinline__ void cmask(f32x16&p0,f32x16&p1,int jb,int qrel,int hi){
  const float NEG=-INFINITY; int kb=64*jb+4*hi;
  #pragma unroll
  for(int r=0;r<16;++r){int kv=kb+(r&3)+8*(r>>2); if(kv>qrel)p0[r]=NEG; if(kv+32>qrel)p1[r]=NEG;}
}
__device__ __forceinline__ void wmask(f32x16&p0,f32x16&p1,int kb0,int qrel,int hi,int W,int PM){
  const float NEG=-INFINITY; const int d0=qrel-kb0-4*hi;
  #pragma unroll
  for(int r=0;r<16;++r){const int d=d0-((r&3)+8*(r>>2)); const int e=d-32;
    if(!(((unsigned)d<=(unsigned)W)&&((d&PM)==0)))p0[r]=NEG;
    if(!(((unsigned)e<=(unsigned)W)&&((e&PM)==0)))p1[r]=NEG;}
}
constexpr int NSLOT=3, SLOTB=8192;
constexpr int LDS_K=0, LDS_V=NSLOT*SLOTB, LDS_WS=2*NSLOT*SLOTB, LDS_OST=LDS_WS+NW*64*4, LDS_BIAS=LDS_OST+NW*4096, TBLN=2304, TPAD=256, LDS_BYTES=LDS_BIAS+TBLN*4;
constexpr float C2=0.125f*1.4426950408889634f;
__device__ __forceinline__ void glds16(const void*gsrc,unsigned lds_dst){unsigned keep;
  asm volatile("s_mov_b32 %0, m0\n\ts_mov_b32 m0, %2\n\ts_nop 0\n\tglobal_load_lds_dwordx4 %1, off\n\ts_mov_b32 m0, %0":"=&s"(keep):"v"(gsrc),"s"(lds_dst):"memory");}
__device__ __forceinline__ float max3f(float a,float b,float c){float r;asm("v_max3_f32 %0, %1, %2, %3":"=v"(r):"v"(a),"v"(b),"v"(c));return r;}
__device__ __forceinline__ float max2f(float a,float b){float r;asm("v_max_f32_e32 %0, %1, %2":"=v"(r):"v"(a),"v"(b));return r;}
__device__ __forceinline__ float fadd_s(float a,float b){float r;asm("v_add_f32_e32 %0, %1, %2":"=v"(r):"v"(a),"v"(b));return r;}
__device__ __forceinline__ float fsub_s(float a,float b){float r;asm("v_sub_f32_e32 %0, %1, %2":"=v"(r):"v"(a),"v"(b));return r;}
typedef float f32x2_t __attribute__((ext_vector_type(2))); typedef __bf16 bf16x2_t __attribute__((ext_vector_type(2)));
__device__ __forceinline__ unsigned cvtpk_s(float lo,float hi){f32x2_t v={lo,hi};bf16x2_t b=__builtin_convertvector(v,bf16x2_t);return __builtin_bit_cast(unsigned,b);}
#define WAIT_BAR(N) asm volatile("s_waitcnt vmcnt(" #N ") lgkmcnt(0)\n\ts_barrier":::"memory")

__device__ __forceinline__ void qkt(f32x16&p0,f32x16&p1,const char*Kslot,const bf16x8*qr,const f32x16&negm,int r32,int hi){
  const char*kb=Kslot+hi*1024+r32*16;
  #pragma unroll
  for(int d0=0;d0<4;++d0){
    const bf16x8 b0=*reinterpret_cast<const bf16x8*>(kb+d0*2048);
    const bf16x8 b1=*reinterpret_cast<const bf16x8*>(kb+d0*2048+512);
    if(d0==0){p0=__builtin_amdgcn_mfma_f32_32x32x16_bf16(b0,qr[0],negm,0,0,0);p1=__builtin_amdgcn_mfma_f32_32x32x16_bf16(b1,qr[0],negm,0,0,0);}
    else{p0=__builtin_amdgcn_mfma_f32_32x32x16_bf16(b0,qr[d0],p0,0,0,0);p1=__builtin_amdgcn_mfma_f32_32x32x16_bf16(b1,qr[d0],p1,0,0,0);}}
}
typedef __attribute__((address_space(3))) const char* lds_cptr;
typedef __attribute__((address_space(3))) const float* lds_fptr;
typedef short v4i16_t __attribute__((ext_vector_type(4)));
__device__ __forceinline__ void kload8(bf16x8*kf,lds_cptr kp){
  kf[0]=*(const __attribute__((address_space(3))) bf16x8*)(kp);      kf[1]=*(const __attribute__((address_space(3))) bf16x8*)(kp+512);
  kf[2]=*(const __attribute__((address_space(3))) bf16x8*)(kp+2048); kf[3]=*(const __attribute__((address_space(3))) bf16x8*)(kp+2560);
  kf[4]=*(const __attribute__((address_space(3))) bf16x8*)(kp+4096); kf[5]=*(const __attribute__((address_space(3))) bf16x8*)(kp+4608);
  kf[6]=*(const __attribute__((address_space(3))) bf16x8*)(kp+6144); kf[7]=*(const __attribute__((address_space(3))) bf16x8*)(kp+6656);
}
__device__ __forceinline__ void kload2(bf16x8*kf,lds_cptr kp,int j){ kf[2*j]=*(const __attribute__((address_space(3))) bf16x8*)(kp+j*2048); kf[2*j+1]=*(const __attribute__((address_space(3))) bf16x8*)(kp+j*2048+512); }
__device__ __forceinline__ s16x4 vtr(lds_cptr p){ return __builtin_bit_cast(s16x4,__builtin_amdgcn_ds_read_tr16_b64_v4i16((__attribute__((address_space(3))) v4i16_t*)p)); }
__device__ __forceinline__ float rowmax(const f32x16&p0,const f32x16&p1){
  float a=max3f(p0[0],p0[1],p1[0]),b=max3f(p0[2],p0[3],p1[1]);a=max3f(a,p1[2],p1[3]);
  #pragma unroll
  for(int r=4;r<16;r+=4){a=max3f(a,p0[r],p0[r+1]);b=max3f(b,p0[r+2],p0[r+3]);a=max3f(a,p1[r],p1[r+1]);b=max3f(b,p1[r+2],p1[r+3]);}
  const float m=max2f(a,b);
  auto rr=__builtin_amdgcn_permlane32_swap(__float_as_uint(m),__float_as_uint(m),false,false);
  return max2f(__uint_as_float(rr[0]),__uint_as_float(rr[1]));
}
__device__ __forceinline__ void pv(f32x16*o,int vb,bf16x8 pa0,bf16x8 pa1,bf16x8 pa2,bf16x8 pa3){
  #pragma unroll
  for(int d0=0;d0<2;++d0){s16x4 lo[4],hi[4];
    #pragma unroll
    for(int ks=0;ks<4;++ks){
      asm volatile("ds_read_b64_tr_b16 %0,%1 offset:%c2":"=&v"(lo[ks]):"v"(vb),"i"(d0*4096+ks*1024):"memory");
      asm volatile("ds_read_b64_tr_b16 %0,%1 offset:%c2":"=&v"(hi[ks]):"v"(vb),"i"(d0*4096+ks*1024+512):"memory");}
    asm volatile("s_waitcnt lgkmcnt(0)":::"memory");SBAR();
    #define PK(k) (bf16x8){lo[k][0],lo[k][1],lo[k][2],lo[k][3],hi[k][0],hi[k][1],hi[k][2],hi[k][3]}
    o[d0]=__builtin_amdgcn_mfma_f32_32x32x16_bf16(pa0,PK(0),o[d0],0,0,0);
    o[d0]=__builtin_amdgcn_mfma_f32_32x32x16_bf16(pa1,PK(1),o[d0],0,0,0);
    o[d0]=__builtin_amdgcn_mfma_f32_32x32x16_bf16(pa2,PK(2),o[d0],0,0,0);
    o[d0]=__builtin_amdgcn_mfma_f32_32x32x16_bf16(pa3,PK(3),o[d0],0,0,0);
    #undef PK
  }
}
__device__ __forceinline__ int t5_bucket(int d){
  if(d<16)return d;
  int b=16; b+=(d>=22); b+=(d>=30); b+=(d>=40); b+=(d>=54); b+=(d>=73); b+=(d>=99); b+=(d>=134); b+=(d>=182); b+=(d>=246); b+=(d>=332); b+=(d>=450); b+=(d>=609); b+=(d>=825); b+=(d>=1117); b+=(d>=1513);
  return b;
}
struct AttnJob {
  const bf16* Q; const bf16* K; const bf16* V; bf16* O; float* LSE;
  int q0, t0, NT;
  int W, PM;
  const float* biasg;
};
#ifndef ATTN_STORE16
#define ATTN_STORE16(p,v) (*(u32x4*)(p)=(v))
#endif
template<int THRL,bool WIN,int R> __device__ __forceinline__ void attn_unit(const AttnJob&J,char*shm){
  int tid_=threadIdx.x; asm volatile("":"+v"(tid_));
  const int tid=tid_,lane=tid&63,r32=lane&31,hi=lane>>5; const int wid=__builtin_amdgcn_readfirstlane(tid>>6);
  constexpr long pin=(long)R*9728; constexpr long pout=WIN?(long)R*512:1024; constexpr long plse=(long)R*8;
  const int q0=J.q0;
  const bf16*Qw=J.Q+(long)(q0+wid*QBLK)*pin;
  const bf16*Kh=J.K+(long)J.t0*KVBLK*pin,*Vh=J.V+(long)J.t0*KVBLK*pin;
  const unsigned lds0=(unsigned)(uintptr_t)shm;
  float*wsf=(float*)(shm+LDS_WS)+wid*64;
  const bf16*ksrc=Kh+(long)lane*pin+wid*8;
  const bf16*vsrc=Vh+(long)(16*(wid&3)+(lane>>2))*pin+(wid>>2)*32+(lane&3)*8;
  const unsigned kdst=lds0+LDS_K+wid*1024, vdst=lds0+LDS_V+wid*1024;
  #define DMA_K(t,slot) glds16(ksrc+(long)(t)*KVBLK*pin,(unsigned)__builtin_amdgcn_readfirstlane(kdst+(slot)))
  #define DMA_V(t,slot) glds16(vsrc+(long)(t)*KVBLK*pin,(unsigned)__builtin_amdgcn_readfirstlane(vdst+(slot)))
  const int vb0=(int)(lds0+LDS_V)+((lane>>4)&1)*32+(lane&3)*8+(4*hi+((lane&15)>>2))*64;
  const char*Kbase=shm+LDS_K; bf16x8 kf[8];
  const lds_cptr shm3=(lds_cptr)shm; const lds_cptr kp0=shm3+LDS_K+hi*1024+r32*16; const lds_cptr vp0=shm3+LDS_V+((lane>>4)&1)*32+(lane&3)*8+(4*hi+((lane&15)>>2))*64;
  const int NT=J.NT-J.t0;
  { const int npieces=(2*TPAD+q0-KVBLK*J.t0+255)>>8;
    for(int pc=wid;pc<npieces;pc+=NW) glds16((const char*)J.biasg+pc*1024+lane*16,(unsigned)__builtin_amdgcn_readfirstlane(lds0+LDS_BIAS+pc*1024)); }
  const lds_fptr Tb3=(lds_fptr)(shm3+LDS_BIAS);
  DMA_K(0,0);DMA_V(0,0);DMA_K(1,SLOTB);
  bf16x8 qr[4];
  #pragma unroll
  for(int d0=0;d0<4;++d0)qr[d0]=*reinterpret_cast<const bf16x8*>(&Qw[(long)r32*pin+d0*16+hi*8]);
  float mhat=0.f,l_reg=0.f;f32x16 o[2];o[0]=f32x16{};o[1]=f32x16{};f32x16 negm=f32x16{};asm volatile("":"+v"(negm));
  const int qrel=wid*QBLK+r32;
  const int tbase=TPAD+qrel-4*hi+64*(NT-4);
  #define BIAS(P0,P1,t) do{ const lds_fptr tp_=Tb3+(tbase-64*(t)); \
    _Pragma("unroll") for(int r=0;r<16;++r){ P0[r]+=tp_[-((r&3)+8*(r>>2))]; P1[r]+=tp_[-32-((r&3)+8*(r>>2))]; } }while(0)
  #define CMASK(P0,P1,t) do{ if(WIN){ wmask(P0,P1,64*((t)-(NT-4)),qrel,hi,J.W,J.PM); } else { int jb_=(t)-(NT-4); if(jb_>=0)cmask(P0,P1,jb_,qrel,hi); } }while(0)
  bool resc=false;
  #define START(P0,P1) do{ const float rm=rowmax(P0,P1); resc=false; \
    { const float dl=WIN?max2f(rm,-1000.f):rm; mhat=fadd_s(mhat,dl); \
      _Pragma("unroll") for(int r=0;r<16;++r){P0[r]=fsub_s(P0[r],dl);P1[r]=fsub_s(P1[r],dl);} \
      _Pragma("unroll") for(int r=0;r<16;++r)negm[r]=-mhat; asm volatile("":"+v"(negm)); } \
    _Pragma("unroll") for(int r=0;r<16;++r)P0[r]=__builtin_amdgcn_exp2f(P0[r]); }while(0)
  #define RESC() do{ if(resc){ asm volatile("s_waitcnt lgkmcnt(0)":::"memory"); \
      _Pragma("unroll") for(int d_=0;d_<2;++d_) _Pragma("unroll") for(int r=0;r<16;++r)o[d_][r]*=wsf[crow(r,hi)]; } }while(0)
  f32x16 pA0,pA1,pB0,pB1;
  int sl_prev=0,sl_cur=0,sl_next=SLOTB;
  #define ROT() do{sl_prev=sl_cur;sl_cur=sl_next;sl_next=(sl_next==(NSLOT-1)*SLOTB)?0:sl_next+SLOTB;}while(0)
  DMA_K(2,2*SLOTB);
  WAIT_BAR(3);
  qkt(pA0,pA1,Kbase,qr,negm,r32,hi);asm volatile("s_nop 15\n\ts_nop 7":"+v"(pA0),"+v"(pA1));BIAS(pA0,pA1,0);CMASK(pA0,pA1,0);
  START(pA0,pA1);
  _Pragma("unroll") for(int r=0;r<16;++r)pA1[r]=__builtin_amdgcn_exp2f(pA1[r]);
  WAIT_BAR(0);
  DMA_K(3,0);DMA_V(1,SLOTB);
  ROT();
  kload8(kf,kp0+sl_cur);
  WAIT_BAR(2);
  s16x4 vlo[8],vhi[8]; u32x4 pw0,pw1,pw2,pw3;
  #define PKW(P,B) cvtpk_s(P[B],P[B+1])
  #define PAF(k) __builtin_bit_cast(bf16x8,pw##k)
  #define VFR(i) (bf16x8){vlo[i][0],vlo[i][1],vlo[i][2],vlo[i][3],vhi[i][0],vhi[i][1],vhi[i][2],vhi[i][3]}
  #define PIN(x) asm volatile("":"+v"(x))
  #define MX3(a,b,c) __builtin_fmaxf(__builtin_fmaxf((a),(b)),(c))
  #define GAPA(MF,A0,A1,A2,A3,W0,W1,PW) do{ MF; sacc+=A0; sacc+=A1; sacc+=A2; sacc+=A3; PIN(sacc); W0; W1; PIN(PW); SBAR(); }while(0)
  #define EX(v) __builtin_amdgcn_exp2f(v)
  #define BLD(bb,OFF) do{ bb[0]=tq_[-(OFF)]; bb[1]=tq_[-(OFF)-1]; bb[2]=tq_[-(OFF)-2]; bb[3]=tq_[-(OFF)-3]; }while(0)
  #define GAPB(MF,X,B,bc,bn,NOFF) do{ if((NOFF)>=0){BLD(bn,NOFF);} MF; X[B]=EX(X[B]+bc[0]); X[B+1]=EX(X[B+1]+bc[1]); X[B+2]=EX(X[B+2]+bc[2]); X[B+3]=EX(X[B+3]+bc[3]); PIN(X); SBAR(); }while(0)
  #define VRD(i) do{ vlo[i]=vtr(vp_+(((i)>>2)*4096+((i)&3)*1024)); vhi[i]=vtr(vp_+(((i)>>2)*4096+((i)&3)*1024+512)); }while(0)
  #define KRD(G,j) do{ if(G){ kload2(kf,kp0+sl_next,j); SBAR(); } }while(0)
  #define STEP(C0,C1,P0,P1,t,GK,GV,GL,MSK) do{ SBAR(); \
    const lds_cptr vp_=vp0+sl_prev; \
    VRD(0); SBAR(); float sacc=(P0[0]+P0[1]); \
    GAPA(C0=__builtin_amdgcn_mfma_f32_32x32x16_bf16(kf[0],qr[0],negm,0,0,0), P0[2],P0[3],P0[4],P0[5],     pw0[0]=PKW(P0,0), pw0[1]=PKW(P0,2), pw0); \
    VRD(4); SBAR(); GAPA(C1=__builtin_amdgcn_mfma_f32_32x32x16_bf16(kf[1],qr[0],negm,0,0,0), P0[6],P0[7],P0[8],P0[9],     pw0[2]=PKW(P0,4), pw0[3]=PKW(P0,6), pw0); \
    VRD(1); SBAR(); GAPA(C0=__builtin_amdgcn_mfma_f32_32x32x16_bf16(kf[2],qr[1],C0,0,0,0),   P0[10],P0[11],P0[12],P0[13], pw1[0]=PKW(P0,8), pw1[1]=PKW(P0,10), pw1); \
    VRD(5); SBAR(); GAPA(C1=__builtin_amdgcn_mfma_f32_32x32x16_bf16(kf[3],qr[1],C1,0,0,0),   P0[14],P0[15],P1[0],P1[1],   pw1[2]=PKW(P0,12),pw1[3]=PKW(P0,14), pw1); \
    VRD(2); SBAR(); GAPA(C0=__builtin_amdgcn_mfma_f32_32x32x16_bf16(kf[4],qr[2],C0,0,0,0),   P1[2],P1[3],P1[4],P1[5],     pw2[0]=PKW(P1,0), pw2[1]=PKW(P1,2), pw2); \
    VRD(6); SBAR(); GAPA(C1=__builtin_amdgcn_mfma_f32_32x32x16_bf16(kf[5],qr[2],C1,0,0,0),   P1[6],P1[7],P1[8],P1[9],     pw2[2]=PKW(P1,4), pw2[3]=PKW(P1,6), pw2); \
    VRD(3); SBAR(); GAPA(C0=__builtin_amdgcn_mfma_f32_32x32x16_bf16(kf[6],qr[3],C0,0,0,0),   P1[10],P1[11],P1[12],P1[13], pw3[0]=PKW(P1,8), pw3[1]=PKW(P1,10), pw3); \
    VRD(7); SBAR(); GAPA(C1=__builtin_amdgcn_mfma_f32_32x32x16_bf16(kf[7],qr[3],C1,0,0,0),   P1[14],P1[15],0.f,0.f,       pw3[2]=PKW(P1,12),pw3[3]=PKW(P1,14), pw3); \
    l_reg+=sacc; \
    if(GK){DMA_K((t)+3,sl_cur);} if(GV){DMA_V((t)+1,sl_next);} \
    if(MSK){CMASK(C0,C1,t);} \
    const lds_fptr tq_=Tb3+(tbase-64*(t)); float bA_[4],bB_[4]; BLD(bA_,0); \
    { float a=MX3(C0[0],C0[1],C1[0]),b=MX3(C0[2],C0[3],C1[1]); a=MX3(a,C1[2],C1[3]); \
      _Pragma("unroll") for(int r=4;r<16;r+=4){a=MX3(a,C0[r],C0[r+1]);b=MX3(b,C0[r+2],C0[r+3]);a=MX3(a,C1[r],C1[r+1]);b=MX3(b,C1[r+2],C1[r+3]);} \
      float rm=__builtin_fmaxf(a,b); { auto rr=__builtin_amdgcn_permlane32_swap(__float_as_uint(rm),__float_as_uint(rm),false,false); rm=__builtin_fmaxf(__uint_as_float(rr[0]),__uint_as_float(rr[1])); } \
      resc=false; \
      if(__builtin_expect(__any(rm>(float)THRL),0)){ const float dl=__builtin_fmaxf(rm,0.f); mhat+=dl; \
        _Pragma("unroll") for(int r=0;r<16;++r){C0[r]-=dl;C1[r]-=dl;} \
        _Pragma("unroll") for(int r=0;r<16;++r)negm[r]=-mhat; asm volatile("":"+v"(negm)); \
        const float f=__builtin_amdgcn_exp2f(-dl); l_reg*=f; if(hi==0)wsf[r32]=f; resc=true; } } \
    SBAR(); \
    GAPB(o[0]=__builtin_amdgcn_mfma_f32_32x32x16_bf16(PAF(0),VFR(0),o[0],0,0,0), C0,0, bA_,bB_,8); \
    GAPB(o[1]=__builtin_amdgcn_mfma_f32_32x32x16_bf16(PAF(0),VFR(4),o[1],0,0,0), C0,4, bB_,bA_,16); \
    KRD(GL,0); GAPB(o[0]=__builtin_amdgcn_mfma_f32_32x32x16_bf16(PAF(1),VFR(1),o[0],0,0,0), C0,8, bA_,bB_,24); \
    KRD(GL,1); GAPB(o[1]=__builtin_amdgcn_mfma_f32_32x32x16_bf16(PAF(1),VFR(5),o[1],0,0,0), C0,12, bB_,bA_,32); \
    KRD(GL,2); GAPB(o[0]=__builtin_amdgcn_mfma_f32_32x32x16_bf16(PAF(2),VFR(2),o[0],0,0,0), C1,0, bA_,bB_,40); \
    KRD(GL,3); GAPB(o[1]=__builtin_amdgcn_mfma_f32_32x32x16_bf16(PAF(2),VFR(6),o[1],0,0,0), C1,4, bB_,bA_,48); \
    GAPB(o[0]=__builtin_amdgcn_mfma_f32_32x32x16_bf16(PAF(3),VFR(3),o[0],0,0,0), C1,8, bA_,bB_,56); \
    GAPB(o[1]=__builtin_amdgcn_mfma_f32_32x32x16_bf16(PAF(3),VFR(7),o[1],0,0,0), C1,12, bB_,bA_,-1); \
    }while(0)
  int t=1;
  if constexpr(!WIN){
  for(;t+5<NT;t+=2){
    STEP(pB0,pB1,pA0,pA1,t,true,true,true,false);     WAIT_BAR(2); RESC(); ROT();
    STEP(pA0,pA1,pB0,pB1,t+1,true,true,true,false);   WAIT_BAR(2); RESC(); ROT();
  }
  }
  #define ENDW(tt) do{ if((tt)+3<NT){WAIT_BAR(2);} else if((tt)+2<NT){WAIT_BAR(1);} else {WAIT_BAR(0);} }while(0)
  for(;t+1<NT;t+=2){
    STEP(pB0,pB1,pA0,pA1,t,(t+3<NT),(t+1<NT),(t+1<NT),true);       ENDW(t);   RESC(); ROT();
    STEP(pA0,pA1,pB0,pB1,t+1,(t+4<NT),(t+2<NT),(t+2<NT),true);     ENDW(t+1); RESC(); ROT();
  }
  STEP(pB0,pB1,pA0,pA1,NT-1,false,false,false,true); RESC();
  { float sacc=pB0[0]+pB0[1]; _Pragma("unroll") for(int r=2;r<16;++r)sacc+=pB0[r]; _Pragma("unroll") for(int r=0;r<16;++r)sacc+=pB1[r]; l_reg+=sacc;
    pw0=(u32x4){PKW(pB0,0),PKW(pB0,2),PKW(pB0,4),PKW(pB0,6)};pw1=(u32x4){PKW(pB0,8),PKW(pB0,10),PKW(pB0,12),PKW(pB0,14)};pw2=(u32x4){PKW(pB1,0),PKW(pB1,2),PKW(pB1,4),PKW(pB1,6)};pw3=(u32x4){PKW(pB1,8),PKW(pB1,10),PKW(pB1,12),PKW(pB1,14)};
    SBAR(); pv(o,vb0+sl_cur,PAF(0),PAF(1),PAF(2),PAF(3)); }
  #undef PKW
  #undef PAF
  #undef VFR
  #undef PIN
  #undef MX3
  #undef GAPA
  #undef GAPB
  #undef BLD
  #undef EX
  #undef VRD
  #undef KRD
  #undef STEP
  #undef ENDW
  {auto rr=__builtin_amdgcn_permlane32_swap(__float_as_uint(l_reg),__float_as_uint(l_reg),false,false);l_reg=__uint_as_float(rr[0])+__uint_as_float(rr[1]);}
  if(J.LSE!=nullptr && hi==0) J.LSE[(long)(q0+qrel)*plse]=(mhat+__builtin_amdgcn_logf(l_reg))*0.6931471805599453f;
  if(hi==0)wsf[32+r32]=l_reg;asm volatile("s_waitcnt lgkmcnt(0)":::"memory");
  float rli[16];
  #pragma unroll
  for(int r=0;r<16;++r)rli[r]=__builtin_amdgcn_rcpf(wsf[32+crow(r,hi)]);
  bf16*Ow=J.O+(long)(q0+wid*QBLK)*pout;
  { bf16*stg=(bf16*)(shm+LDS_OST)+wid*2048;
    #pragma unroll
    for(int r=0;r<16;++r){const int orow=crow(r,hi);
      #pragma unroll
      for(int d0=0;d0<2;++d0)stg[orow*64+d0*32+r32]=__float2bfloat16(o[d0][r]*rli[r]);}
    asm volatile("s_waitcnt lgkmcnt(0)":::"memory");
    #pragma unroll
    for(int i=0;i<4;++i){const int row=i*8+(lane>>3),ch=lane&7; const u32x4 v=*(const u32x4*)(stg+row*64+ch*8); ATTN_STORE16(Ow+(long)row*pout+ch*8,v);} }
  asm volatile("s_waitcnt lgkmcnt(0)\n\ts_barrier":::"memory");
  #undef DMA_K
  #undef DMA_V
  #undef CMASK
  #undef BIAS
  #undef START
  #undef RESC
  #undef ROT
}
constexpr int ATTN_LDS_BYTES=LDS_BYTES;
#undef SBAR
#undef WAIT_BAR
}
constexpr int NWAVES = 8;
constexpr int NB = 8, SEQ = 2048, DM = 1024, DEPTH = 4, M = NB * SEQ;
constexpr int INW = 9728;
constexpr int COL_QA = 0, COL_KA = 1536, COL_VA = 3072, COL_QB = 4608, COL_KB = 5632, COL_VB = 6656, COL_GA = 7680, COL_GB = 8704;
constexpr int NEXP = 16384, PHEADS = 8, TOPK = 16, PQW = 2048;
constexpr float NORM_EPS = 1e-6f, SUBLN_EPS = 1e-5f;
constexpr size_t MiB = 1u << 20;
constexpr size_t WS_CTL = 0, CTL_ZERO_BYTES = 1 * MiB;
constexpr size_t WS_MOD = 1 * MiB;
constexpr size_t WS_SUBK = 2 * MiB;
constexpr size_t WS_BIAS = 3 * MiB;
constexpr size_t WS_WPA = 4 * MiB;
constexpr size_t WS_WPB = 8 * MiB;
constexpr size_t WS_WO = 16 * MiB;
constexpr size_t WS_WQ = 24 * MiB;
constexpr size_t WS_WIN = 40 * MiB;
constexpr size_t WS_U = 116 * MiB;
constexpr size_t WS_V = 244 * MiB;
constexpr size_t WS_H = 372 * MiB;
constexpr size_t WS_PROJ = 404 * MiB;
constexpr size_t WS_PQ = WS_PROJ;
constexpr size_t WS_IDS = WS_PROJ + 64 * MiB;
constexpr size_t WS_GATES = WS_PROJ + 72 * MiB;
constexpr size_t WS_ODIFF = 708 * MiB;
constexpr size_t WS_TMP = WS_ODIFF;
constexpr size_t WS_ODIL = 772 * MiB;
constexpr size_t WS_MERGED = WS_ODIL;
constexpr size_t WS_LSE = 820 * MiB;
constexpr size_t WS_OA = 822 * MiB;
constexpr size_t WS_OB = 838 * MiB;
constexpr size_t WS_END = 870 * MiB;
constexpr size_t WS_DBG = 880 * MiB;
constexpr int CW_BAR = 4096;
constexpr int RING_BYTES = 131072;
constexpr int LDSCTL_OFF = RING_BYTES, MISC_OFF = LDSCTL_OFF + 320;
constexpr int LDS_BYTES = 147456;
constexpr int PH_PRO_A = 0, PH_PRO_B = 1, PH_LAYER0 = 2, PH_PER_LAYER = 9, NPHASE = PH_LAYER0 + DEPTH * PH_PER_LAYER;

#define GAS __attribute__((address_space(1)))
#define LAS __attribute__((address_space(3)))
typedef unsigned short bf16;
typedef unsigned v4u __attribute__((ext_vector_type(4)));
typedef unsigned v2u __attribute__((ext_vector_type(2)));
typedef float f32x4 __attribute__((ext_vector_type(4)));
typedef float f32x16 __attribute__((ext_vector_type(16)));
typedef short bf16x8 __attribute__((ext_vector_type(8)));
typedef __bf16 bf16x2_t __attribute__((ext_vector_type(2)));
typedef GAS unsigned gu32;
#define RLX_AGENT __ATOMIC_RELAXED, __HIP_MEMORY_SCOPE_AGENT
#define LDS_WAIT() asm volatile("s_waitcnt lgkmcnt(0)" ::: "memory")
#define VM_WAIT() asm volatile("s_waitcnt vmcnt(0)" ::: "memory")
__device__ __forceinline__ unsigned f2bf(float f) { unsigned u = __builtin_bit_cast(unsigned, f); return (u + 0x7fffu + ((u >> 16) & 1u)) >> 16; }
__device__ __forceinline__ unsigned pk2(float lo, float hi) { return f2bf(lo) | (f2bf(hi) << 16); }
__device__ __forceinline__ float bflo(unsigned w) { return __uint_as_float(w << 16); }
__device__ __forceinline__ float bfhi(unsigned w) { return __uint_as_float(w & 0xffff0000u); }
#define XB_TMO      128
#define XB_XCNT(j)  (256  + 64 * (j))
#define XB_XSUB(j)  (1280 + 64 * (j))
#define XB_XGEN(j)  (2304 + 64 * (j))
#define XB_TOP      3328
#define XB_TOPGEN   3392
#define XCD_BAR_WORDS 3456
#define XB_SPIN_CAP (1u << 18)

__device__ __forceinline__ unsigned xb_ld(unsigned* p)              { return __hip_atomic_load(p, __ATOMIC_RELAXED, __HIP_MEMORY_SCOPE_AGENT); }
__device__ __forceinline__ unsigned xb_add(unsigned* p, unsigned v) { return __hip_atomic_fetch_add(p, v, __ATOMIC_RELAXED, __HIP_MEMORY_SCOPE_AGENT); }
__device__ __forceinline__ unsigned xb_xcc_id() { return (unsigned)__builtin_amdgcn_s_getreg((3 << 11) | 20) & 0xFu; }
#define XB_SPIN(cond, bar) do { unsigned _sp = 0; while (cond) { __builtin_amdgcn_s_sleep(1); \
    if ((++_sp & 255u) == 0u) { if (xb_ld(&(bar)[XB_TMO])) break; if (_sp > XB_SPIN_CAP) { atomicAdd(&(bar)[XB_TMO], 1u); break; } } } } while (0)

struct XcdBarrier {
    unsigned* bar; unsigned x;
    volatile LAS unsigned* st;
};

__device__ __forceinline__ XcdBarrier xcd_barrier_post(unsigned* bar, volatile LAS unsigned* st) {
    XcdBarrier b; b.bar = bar; b.x = xb_xcc_id(); b.st = st;
    if (threadIdx.x == 0) (void)xb_add(&bar[XB_XCNT(b.x)], 1u);
    return b;
}
__device__ __forceinline__ void xcd_barrier_complete(unsigned* bar, unsigned x, unsigned& nloc, unsigned& nx) {
    const unsigned G = gridDim.x * gridDim.y * gridDim.z;
    unsigned sum, cnt, mine, sp = 0u;
    for (;;) {
        sum = 0u; cnt = 0u; mine = 0u;
#pragma unroll
        for (unsigned j = 0; j < 16; ++j) { const unsigned c = xb_ld(&bar[XB_XCNT(j)]); sum += c; cnt += (c > 0u) ? 1u : 0u; mine = (j == x) ? c : mine; }
        if (sum == G) break;
        __builtin_amdgcn_s_sleep(1);
        if ((++sp & 255u) == 0u) { if (xb_ld(&bar[XB_TMO])) break; if (sp > XB_SPIN_CAP) { atomicAdd(&bar[XB_TMO], 1u); break; } }
    }
    nloc = mine > 0u ? mine : 1u; nx = cnt > 0u ? cnt : 1u;
}

__device__ __forceinline__ void xcd_barrier(const XcdBarrier& b) {
    asm volatile("s_waitcnt vmcnt(0)" ::: "memory");
    __syncthreads();
    if (threadIdx.x == 0) {
        unsigned* bar = b.bar;
        __builtin_amdgcn_s_waitcnt(0);
        unsigned nloc = b.st[0], nx = b.st[1];
        if (nloc == 0u) { xcd_barrier_complete(bar, b.x, nloc, nx); b.st[0] = nloc; b.st[1] = nx; }
        const unsigned old = xb_add(&bar[XB_XSUB(b.x)], 1u);
        const unsigned gen = old / nloc;
        if (old + 1u == (gen + 1u) * nloc) {
            __builtin_amdgcn_fence(__ATOMIC_RELEASE, "agent");
            asm volatile("s_waitcnt vmcnt(0)" ::: "memory");
            const unsigned og = xb_add(&bar[XB_TOP], 1u);
            const unsigned tg = og / nx;
            if (og + 1u == (tg + 1u) * nx) xb_add(&bar[XB_TOPGEN], 1u);
            else XB_SPIN(xb_ld(&bar[XB_TOPGEN]) == tg, bar);
            __builtin_amdgcn_fence(__ATOMIC_ACQUIRE, "agent");
            xb_add(&bar[XB_XGEN(b.x)], 1u);
            asm volatile("s_waitcnt vmcnt(0)" ::: "memory");
        } else {
            XB_SPIN(xb_ld(&bar[XB_XGEN(b.x)]) == gen, bar);
            __builtin_amdgcn_fence(__ATOMIC_ACQUIRE, "agent");
            asm volatile("s_waitcnt vmcnt(0)" ::: "memory");
        }
    }
    __syncthreads();
}
struct Args { const float* in[21]; float* out; unsigned char* ws; int ph_lo, ph_hi; };
struct Frame {
    LAS unsigned char* lds; unsigned char* ldsg;
    int tid, lane, wave, vcu, G;
};
__device__ __forceinline__ float wave_sum(float v) {
#pragma unroll
    for (int o = 1; o < 64; o <<= 1) v += __shfl_xor(v, o);
    return v;
}
__device__ __forceinline__ void p0_transpose_item(const float* W, int K, int N, bf16* WT, LAS float* scr, int item, int lane) {
    const int nblk = N / 32, kb = item / nblk, nb = item % nblk, k0 = 64 * kb, n0 = 32 * nb;
#pragma unroll 8
    for (int i = 0; i < 32; ++i) { const int kk = 2 * i + (lane >> 5); scr[kk * 33 + (lane & 31)] = W[(size_t)(k0 + kk) * N + n0 + (lane & 31)]; }
    LDS_WAIT(); asm volatile("" ::: "memory");
    const int c = lane & 7;
#pragma unroll
    for (int j = 0; j < 4; ++j) { const int n = (lane >> 3) + 8 * j; const LAS float* s = scr + (8 * c) * 33 + n;
        v4u o; o.x = pk2(s[0 * 33], s[1 * 33]); o.y = pk2(s[2 * 33], s[3 * 33]); o.z = pk2(s[4 * 33], s[5 * 33]); o.w = pk2(s[6 * 33], s[7 * 33]);
        *(GAS v4u*)(WT + (size_t)(n0 + n) * K + k0 + 8 * c) = o; }
    LDS_WAIT(); asm volatile("" ::: "memory");
}
__device__ __forceinline__ void cvt_stream(const float* src, bf16* dst, size_t nchunks, size_t gtid, size_t nthreads) {
    for (size_t c = gtid; c < nchunks; c += nthreads) { const f32x4 a = *(const GAS f32x4*)(src + c * 8), b = *(const GAS f32x4*)(src + c * 8 + 4);
        v4u o; o.x = pk2(a.x, a.y); o.y = pk2(a.z, a.w); o.z = pk2(b.x, b.y); o.w = pk2(b.z, b.w); *(GAS v4u*)(dst + c * 8) = o; }
}
__device__ __forceinline__ void prologue_a(Frame& F, const Args& A) {
    const int gw = F.vcu * NWAVES + F.wave, NGW = F.G * NWAVES;
    { LAS float* scr = (LAS float*)(F.lds + F.wave * 16384);
      constexpr int I_IN = (DM / 64) * (INW / 32), I_PA = (512 / 64) * (DM / 32), I_PB = (DM / 64) * (DM / 32), I_O = I_PB, I_Q = (DM / 64) * (PQW / 32);
      constexpr int PER_L = I_IN + I_PA + I_PB + I_O + I_Q, NITEMS = DEPTH * PER_L;
      for (int it = gw; it < NITEMS; it += NGW) {
          const int l = it / PER_L; int r = it % PER_L;
          if (r < I_IN) { p0_transpose_item(A.in[6] + (size_t)l * DM * INW, DM, INW, (bf16*)(A.ws + WS_WIN) + (size_t)l * INW * DM, scr, r, F.lane); continue; } r -= I_IN;
          if (r < I_PA) { p0_transpose_item(A.in[7] + (size_t)l * 512 * DM, 512, DM, (bf16*)(A.ws + WS_WPA) + (size_t)l * DM * 512, scr, r, F.lane); continue; } r -= I_PA;
          if (r < I_PB) { p0_transpose_item(A.in[8] + (size_t)l * DM * DM, DM, DM, (bf16*)(A.ws + WS_WPB) + (size_t)l * DM * DM, scr, r, F.lane); continue; } r -= I_PB;
          if (r < I_O) { p0_transpose_item(A.in[9] + (size_t)l * DM * DM, DM, DM, (bf16*)(A.ws + WS_WO) + (size_t)l * DM * DM, scr, r, F.lane); continue; } r -= I_O;
          p0_transpose_item(A.in[16] + (size_t)l * DM * PQW, DM, PQW, (bf16*)(A.ws + WS_WQ) + (size_t)l * PQW * DM, scr, r, F.lane);
      } }
    { const size_t gtid = (size_t)gw * 64 + F.lane, nthr = (size_t)NGW * 64;
      cvt_stream(A.in[18], (bf16*)(A.ws + WS_U), (size_t)DEPTH * NEXP * DM / 8, gtid, nthr);
      cvt_stream(A.in[19], (bf16*)(A.ws + WS_V), (size_t)DEPTH * NEXP * DM / 8, gtid, nthr);
      cvt_stream(A.in[17], (bf16*)(A.ws + WS_SUBK), (size_t)DEPTH * 2 * 128 * 128 / 8, gtid, nthr);
      float* BT = (float*)(A.ws + WS_BIAS);
      for (size_t i = gtid; i < (size_t)32 * attn_body::TBLN; i += nthr) { const int hd = (int)(i / attn_body::TBLN), d = (int)(i % attn_body::TBLN) - attn_body::TPAD;
          const int st = (hd < 8 || hd >= 24) ? 1 : (hd < 16 ? 4 : 8); float v = 0.f;
          if (d >= 0) { int dist = d * st; dist = dist > 2047 ? 2047 : dist; v = A.in[15][attn_body::t5_bucket(dist) * 32 + hd] * 1.4426950408889634f; }
          BT[i] = v; } }
    __syncthreads();
    { LAS float* sil = (LAS float*)F.lds;
      LAS float* red = (LAS float*)(F.lds + 32768);
      for (int i = F.tid; i < NB * DM; i += NWAVES * 64) { const float v = A.in[1][i]; sil[i] = v / (1.0f + __expf(-v)); }
      __syncthreads();
      constexpr int NJB = 6 * DM / 64;
      for (int u = F.vcu; u < DEPTH * NJB; u += F.G) {
          const int l = u / NJB, jb = u % NJB, j = jb * 64 + F.lane;
          const float* Wp = A.in[2] + (size_t)l * DM * 6 * DM + (size_t)(F.wave * 128) * 6 * DM + j;
          float acc[8];
#pragma unroll
          for (int b = 0; b < 8; ++b) acc[b] = 0.f;
#pragma unroll 8
          for (int k = 0; k < 128; ++k) { const float w = Wp[(size_t)k * 6 * DM];
#pragma unroll
              for (int b = 0; b < 8; ++b) acc[b] += sil[b * DM + F.wave * 128 + k] * w; }
#pragma unroll
          for (int b = 0; b < 8; ++b) red[(F.wave * 8 + b) * 64 + F.lane] = acc[b];
          __syncthreads();
          { const int b = F.tid >> 6, ln = F.tid & 63; float s = 0.f;
#pragma unroll
            for (int w = 0; w < 8; ++w) s += red[(w * 8 + b) * 64 + ln];
            ((float*)(A.ws + WS_MOD))[((size_t)l * NB + b) * 6 * DM + jb * 64 + ln] = s + A.in[3][(size_t)l * 6 * DM + jb * 64 + ln]; }
          __syncthreads();
      } }
}
__device__ __forceinline__ void norm_row_store(const f32x4 (&v)[4], const float* g, const float* sc, const float* sh, bf16* orow, int lane) {
    float s = 0.f;
#pragma unroll
    for (int j = 0; j < 4; ++j) s += (v[j].x * v[j].x + v[j].y * v[j].y) + (v[j].z * v[j].z + v[j].w * v[j].w);
    const float r = 1.0f / sqrtf(wave_sum(s) * (1.0f / DM) + NORM_EPS);
    GAS v2u* o8 = (GAS v2u*)orow + lane;
#pragma unroll
    for (int j = 0; j < 4; ++j) { const int c = 4 * lane + 256 * j; const f32x4 gg = *(const f32x4*)(g + c), cc = *(const f32x4*)(sc + c), hh = *(const f32x4*)(sh + c);
        const f32x4 y = v[j] * r * gg * (cc + 1.0f) + hh; v2u w; w.x = pk2(y.x, y.y); w.y = pk2(y.z, y.w); o8[64 * j] = w; }
}
__device__ __forceinline__ void prologue_b(Frame& F, const Args& A) {
    const int gw = F.vcu * NWAVES + F.wave, NGW = F.G * NWAVES;
    const float* mod = (const float*)(A.ws + WS_MOD);
    for (int m = gw; m < M; m += NGW) { const int b = m / SEQ;
        const GAS f32x4* xr = (const GAS f32x4*)(A.in[0] + (size_t)m * DM) + F.lane; GAS f32x4* xo = (GAS f32x4*)(A.out + (size_t)m * DM) + F.lane;
        f32x4 v[4];
#pragma unroll
        for (int j = 0; j < 4; ++j) { v[j] = xr[64 * j]; xo[64 * j] = v[j]; }
        norm_row_store(v, A.in[4], mod + (size_t)b * 6 * DM + 1 * DM, mod + (size_t)b * 6 * DM + 0 * DM, (bf16*)(A.ws + WS_H) + (size_t)m * DM, F.lane); }
}
__device__ __forceinline__ void norm2_phase(Frame& F, const Args& A, int l) {
    const int gw = F.vcu * NWAVES + F.wave, NGW = F.G * NWAVES;
    const float* mod = (const float*)(A.ws + WS_MOD) + (size_t)l * NB * 6 * DM;
    for (int m = gw; m < M; m += NGW) { const int b = m / SEQ;
        const GAS f32x4* xr = (const GAS f32x4*)(A.out + (size_t)m * DM) + F.lane;
        f32x4 v[4];
#pragma unroll
        for (int j = 0; j < 4; ++j) v[j] = xr[64 * j];
        norm_row_store(v, A.in[5] + (size_t)l * DM, mod + (size_t)b * 6 * DM + 4 * DM, mod + (size_t)b * 6 * DM + 3 * DM, (bf16*)(A.ws + WS_H) + (size_t)m * DM, F.lane); }
}
__device__ __forceinline__ void attn_phase_all(Frame& F, const Args& A) {
    using namespace attn_body;
    const __hip_bfloat16* P = (const __hip_bfloat16*)(A.ws + WS_PROJ);
    __hip_bfloat16* OD = (__hip_bfloat16*)(A.ws + WS_ODIFF); __hip_bfloat16* OG = (__hip_bfloat16*)(A.ws + WS_ODIL); float* LS = (float*)(A.ws + WS_LSE);
    const float* BT = (const float*)(A.ws + WS_BIAS);
    constexpr int NUNITS = 14 * 256;
    for (int L = F.vcu; L < NUNITS; L += F.G) {
        const int round = L >> 8, c = L & 255;
        AttnJob J;
        if (round < 8) {
            const int b = c >> 5, h = (c >> 2) & 7, sub = (c >> 1) & 1, vh = c & 1; const int qb = (round & 1) ? (round >> 1) : 7 - (round >> 1);
            const size_t rb = (size_t)b * SEQ;
            J.Q = P + rb * INW + COL_QB + h * 128 + sub * 64; J.K = P + rb * INW + COL_KB + h * 128 + sub * 64; J.V = P + rb * INW + COL_VB + h * 128 + vh * 64;
            J.O = OD + (size_t)sub * M * DM + rb * DM + h * 128 + vh * 64; J.LSE = nullptr;
            J.q0 = 256 * qb; J.t0 = 0; J.NT = 4 * qb + 4; J.W = 0; J.PM = 0; J.biasg = BT + (size_t)(24 + h) * attn_body::TBLN;
            attn_unit<8, false, 1>(J, (char*)F.ldsg);
        } else {
            int g, b, h, m, qb, r, W, PM;
            const int u = 2 * c + (round & 1);
            if (round < 10) { g = 0; b = u >> 6; h = (u >> 3) & 7; m = 0; qb = u & 7; r = 1; W = 128; PM = 0; }
            else if (round < 12) { g = 1; b = u >> 6; h = (u >> 3) & 7; m = (u >> 1) & 3; qb = u & 1; r = 4; W = 128; PM = 0; }
            else { g = 2; b = u >> 6; h = (u >> 3) & 7; m = u & 7; qb = 0; r = 8; W = 256; PM = 1; }
            const size_t rb = (size_t)b * SEQ + m;
            J.Q = P + rb * INW + COL_QA + g * 512 + h * 64; J.K = P + rb * INW + COL_KA + g * 512 + h * 64; J.V = P + rb * INW + COL_VA + g * 512 + h * 64;
            J.O = OG + (size_t)g * M * 512 + rb * 512 + h * 64; J.LSE = LS + (size_t)g * M * 8 + rb * 8 + h;
            J.q0 = 256 * qb; J.t0 = (qb > 0) ? 4 * qb - 2 : 0; J.NT = 4 * qb + 4; J.W = W; J.PM = PM; J.biasg = BT + (size_t)(8 * g + h) * attn_body::TBLN;
            if (g == 0) attn_unit<8, true, 1>(J, (char*)F.ldsg); else if (g == 1) attn_unit<8, true, 4>(J, (char*)F.ldsg); else attn_unit<8, true, 8>(J, (char*)F.ldsg);
        }
    }
}
__device__ __forceinline__ void combine_phase(Frame& F, const Args& A, int l) {
    const int gw = F.vcu * NWAVES + F.wave, NGW = F.G * NWAVES, lane = F.lane;
    const float lam_init = 0.8f - 0.6f * expf(-0.3f * (float)l);
    const float d1 = wave_sum(A.in[10][l * 64 + lane] * A.in[11][l * 64 + lane]), d2 = wave_sum(A.in[12][l * 64 + lane] * A.in[13][l * 64 + lane]);
    const float lam = expf(d1) - expf(d2) + lam_init;
    const bf16* OG = (const bf16*)(A.ws + WS_ODIL); const float* LS = (const float*)(A.ws + WS_LSE); const bf16* OD = (const bf16*)(A.ws + WS_ODIFF);
    bf16* OA = (bf16*)(A.ws + WS_OA); bf16* OB = (bf16*)(A.ws + WS_OB);
    const int hd = lane >> 3, c8 = (lane & 7) * 8, c16 = (lane & 7) * 16;
    float sg[16];
#pragma unroll
    for (int i = 0; i < 16; ++i) sg[i] = A.in[14][l * 128 + c16 + i] * (1.0f - lam_init);
    for (int t = gw; t < M; t += NGW) {
        { const float l0 = LS[(size_t)t * 8 + hd], l1 = LS[(size_t)M * 8 + (size_t)t * 8 + hd], l2 = LS[(size_t)2 * M * 8 + (size_t)t * 8 + hd];
          const float mx = fmaxf(l0, fmaxf(l1, l2)); float w0 = __expf(l0 - mx), w1 = __expf(l1 - mx), w2 = __expf(l2 - mx); const float inv = 1.0f / (w0 + w1 + w2); w0 *= inv; w1 *= inv; w2 *= inv;
          const v4u a = *(const GAS v4u*)(OG + (size_t)t * 512 + hd * 64 + c8), b = *(const GAS v4u*)(OG + (size_t)M * 512 + (size_t)t * 512 + hd * 64 + c8), c = *(const GAS v4u*)(OG + (size_t)2 * M * 512 + (size_t)t * 512 + hd * 64 + c8);
          v4u o;
          o.x = pk2(w0 * bflo(a.x) + w1 * bflo(b.x) + w2 * bflo(c.x), w0 * bfhi(a.x) + w1 * bfhi(b.x) + w2 * bfhi(c.x));
          o.y = pk2(w0 * bflo(a.y) + w1 * bflo(b.y) + w2 * bflo(c.y), w0 * bfhi(a.y) + w1 * bfhi(b.y) + w2 * bfhi(c.y));
          o.z = pk2(w0 * bflo(a.z) + w1 * bflo(b.z) + w2 * bflo(c.z), w0 * bfhi(a.z) + w1 * bfhi(b.z) + w2 * bfhi(c.z));
          o.w = pk2(w0 * bflo(a.w) + w1 * bflo(b.w) + w2 * bflo(c.w), w0 * bfhi(a.w) + w1 * bfhi(b.w) + w2 * bfhi(c.w));
          *(GAS v4u*)(OA + (size_t)t * 512 + hd * 64 + c8) = o; }
        { const bf16* p0 = OD + (size_t)t * DM + hd * 128 + c16; const bf16* p1 = OD + (size_t)M * DM + (size_t)t * DM + hd * 128 + c16;
          const v4u a0 = *(const GAS v4u*)p0, a1 = *(const GAS v4u*)(p0 + 8), b0 = *(const GAS v4u*)p1, b1 = *(const GAS v4u*)(p1 + 8);
          float o[16];
          o[0] = bflo(a0.x) - lam * bflo(b0.x); o[1] = bfhi(a0.x) - lam * bfhi(b0.x); o[2] = bflo(a0.y) - lam * bflo(b0.y); o[3] = bfhi(a0.y) - lam * bfhi(b0.y);
          o[4] = bflo(a0.z) - lam * bflo(b0.z); o[5] = bfhi(a0.z) - lam * bfhi(b0.z); o[6] = bflo(a0.w) - lam * bflo(b0.w); o[7] = bfhi(a0.w) - lam * bfhi(b0.w);
          o[8] = bflo(a1.x) - lam * bflo(b1.x); o[9] = bfhi(a1.x) - lam * bfhi(b1.x); o[10] = bflo(a1.y) - lam * bflo(b1.y); o[11] = bfhi(a1.y) - lam * bfhi(b1.y);
          o[12] = bflo(a1.z) - lam * bflo(b1.z); o[13] = bfhi(a1.z) - lam * bfhi(b1.z); o[14] = bflo(a1.w) - lam * bflo(b1.w); o[15] = bfhi(a1.w) - lam * bfhi(b1.w);
          float ss = 0.f;
#pragma unroll
          for (int i = 0; i < 16; ++i) ss += o[i] * o[i];
          ss += __shfl_xor(ss, 1); ss += __shfl_xor(ss, 2); ss += __shfl_xor(ss, 4);
          const float r = 1.0f / sqrtf(ss * (1.0f / 128.0f) + SUBLN_EPS);
          v4u w0, w1;
          w0.x = pk2(o[0] * r * sg[0], o[1] * r * sg[1]); w0.y = pk2(o[2] * r * sg[2], o[3] * r * sg[3]); w0.z = pk2(o[4] * r * sg[4], o[5] * r * sg[5]); w0.w = pk2(o[6] * r * sg[6], o[7] * r * sg[7]);
          w1.x = pk2(o[8] * r * sg[8], o[9] * r * sg[9]); w1.y = pk2(o[10] * r * sg[10], o[11] * r * sg[11]); w1.z = pk2(o[12] * r * sg[12], o[13] * r * sg[13]); w1.w = pk2(o[14] * r * sg[14], o[15] * r * sg[15]);
          bf16* q = OB + (size_t)t * DM + hd * 128 + c16; *(GAS v4u*)q = w0; *(GAS v4u*)(q + 8) = w1; }
    }
}
#define CE_DESC(a, b) do { const float _hi = fmaxf(a, b), _lo = fminf(a, b); a = _hi; b = _lo; } while (0)
__device__ __forceinline__ void sort16_desc(float (&v)[16]) {
#pragma unroll
    for (int k = 2; k <= 16; k <<= 1)
#pragma unroll
        for (int j = k >> 1; j > 0; j >>= 1)
#pragma unroll
            for (int i = 0; i < 16; ++i) { const int p = i ^ j; if (p > i) { if ((i & k) == 0) { CE_DESC(v[i], v[p]); } else { CE_DESC(v[p], v[i]); } } }
}
__device__ __forceinline__ void merge16_desc(float (&a)[16], const float (&b)[16]) {
#pragma unroll
    for (int i = 0; i < 16; ++i) a[i] = fmaxf(a[i], b[15 - i]);
#pragma unroll
    for (int j = 8; j > 0; j >>= 1)
#pragma unroll
        for (int i = 0; i < 16; ++i) { const int p = i ^ j; if (p > i) CE_DESC(a[i], a[p]); }
}
__device__ __forceinline__ float pack_idx(float v, unsigned idx, unsigned mask) { return __uint_as_float((__float_as_uint(v) & ~mask) | idx); }
__device__ __forceinline__ void topk_phase(Frame& F, const Args& A, int l) {
    const int gw = F.vcu * NWAVES + F.wave, NGW = F.G * NWAVES, lane = F.lane, r32 = lane & 31, hi = lane >> 5;
    { const bf16* SK = (const bf16*)(A.ws + WS_SUBK) + (size_t)l * 2 * 128 * 128;
      for (int c = F.tid; c < 256 * 16; c += NWAVES * 64) { const int row = c >> 4, ch = c & 15; const v4u v = *(const GAS v4u*)(SK + row * 128 + ch * 8); *(LAS v4u*)(F.lds + row * 272 + ch * 16) = v; }
      __syncthreads(); }
    LAS unsigned char* sk = F.lds;
    LAS unsigned char* ibuf = F.lds + 69632 + F.wave * 2048 + lane * 32;
    const bf16* PQ = (const bf16*)(A.ws + WS_PQ);
    int* IDS = (int*)(A.ws + WS_IDS); float* GT = (float*)(A.ws + WS_GATES);
    for (int unit = gw; unit < (M / 32) * PHEADS; unit += NGW) {
        const int tile = unit >> 3, h = unit & 7, tok = tile * 32 + r32;
        const bf16* qrow = PQ + (size_t)tok * PQW + h * 256;
        float X[64], Y[64];
#pragma unroll
        for (int p = 0; p < 2; ++p) {
            bf16x8 qf[8];
#pragma unroll
            for (int k0 = 0; k0 < 8; ++k0) qf[k0] = *(const GAS bf16x8*)(qrow + p * 128 + k0 * 16 + hi * 8);
#pragma unroll
            for (int kb = 0; kb < 4; ++kb) { f32x16 acc = f32x16{};
                const LAS unsigned char* ap = sk + (p * 128 + kb * 32 + r32) * 272 + hi * 16;
#pragma unroll
                for (int k0 = 0; k0 < 8; ++k0) { const bf16x8 a = *(const LAS bf16x8*)(ap + k0 * 32); acc = __builtin_amdgcn_mfma_f32_32x32x16_bf16(a, qf[k0], acc, 0, 0, 0); }
#pragma unroll
                for (int r = 0; r < 16; ++r) { if (p == 0) X[kb * 16 + r] = acc[r]; else Y[kb * 16 + r] = acc[r]; } }
        }
#pragma unroll
        for (int i = 0; i < 64; ++i) { auto rr = __builtin_amdgcn_permlane32_swap(__float_as_uint(X[i]), __float_as_uint(Y[i]), false, false); X[i] = __uint_as_float(rr[0]); Y[i] = __uint_as_float(rr[1]); }
#pragma unroll
        for (int i = 0; i < 64; ++i) { const unsigned key = 32u * (i >> 4) + (unsigned)((i & 3) + 8 * ((i & 15) >> 2)); X[i] = pack_idx(X[i], key, 127u); Y[i] = pack_idx(Y[i], key + 4u, 127u); }
        float top[16];
        { float g0[16], g1[16];
#pragma unroll
          for (int i = 0; i < 16; ++i) { top[i] = X[i]; g0[i] = X[16 + i]; }
          sort16_desc(top); sort16_desc(g0); merge16_desc(top, g0);
#pragma unroll
          for (int i = 0; i < 16; ++i) { g0[i] = X[32 + i]; g1[i] = X[48 + i]; }
          sort16_desc(g0); sort16_desc(g1); merge16_desc(g0, g1); merge16_desc(top, g0);
#pragma unroll
          for (int i = 0; i < 16; ++i) { g0[i] = Y[i]; g1[i] = Y[16 + i]; }
          sort16_desc(g0); sort16_desc(g1); merge16_desc(g0, g1); merge16_desc(top, g0);
#pragma unroll
          for (int i = 0; i < 16; ++i) { g0[i] = Y[32 + i]; g1[i] = Y[48 + i]; }
          sort16_desc(g0); sort16_desc(g1); merge16_desc(g0, g1); merge16_desc(top, g0); }
        float a[16], b[16];
#pragma unroll
        for (int i = 0; i < 16; ++i) { auto rr = __builtin_amdgcn_permlane32_swap(__float_as_uint(top[i]), __float_as_uint(top[i]), false, false); a[i] = __uint_as_float(rr[0]); b[i] = __uint_as_float(rr[1]); }
        { unsigned wa[4], wb[4];
#pragma unroll
          for (int q = 0; q < 4; ++q) { wa[q] = (__float_as_uint(a[4 * q]) & 127u) | ((__float_as_uint(a[4 * q + 1]) & 127u) << 8) | ((__float_as_uint(a[4 * q + 2]) & 127u) << 16) | ((__float_as_uint(a[4 * q + 3]) & 127u) << 24);
                                         wb[q] = (__float_as_uint(b[4 * q]) & 127u) | ((__float_as_uint(b[4 * q + 1]) & 127u) << 8) | ((__float_as_uint(b[4 * q + 2]) & 127u) << 16) | ((__float_as_uint(b[4 * q + 3]) & 127u) << 24); }
          *(LAS v4u*)ibuf = (v4u){wa[0], wa[1], wa[2], wa[3]}; *(LAS v4u*)(ibuf + 16) = (v4u){wb[0], wb[1], wb[2], wb[3]}; }
        float c0[16], c1[16], c2[16], c3[16];
        { const float NEGI = -INFINITY;
#define CAND(i, j) pack_idx(a[i] + b[j], (unsigned)(((i) << 4) | (j)), 255u)
          c0[0] = CAND(0, 0); c0[1] = CAND(0, 1); c0[2] = CAND(0, 2); c0[3] = CAND(0, 3); c0[4] = CAND(0, 4); c0[5] = CAND(0, 5); c0[6] = CAND(0, 6); c0[7] = CAND(0, 7);
          c0[8] = CAND(0, 8); c0[9] = CAND(0, 9); c0[10] = CAND(0, 10); c0[11] = CAND(0, 11); c0[12] = CAND(0, 12); c0[13] = CAND(0, 13); c0[14] = CAND(0, 14); c0[15] = CAND(0, 15);
          c1[0] = CAND(1, 0); c1[1] = CAND(1, 1); c1[2] = CAND(1, 2); c1[3] = CAND(1, 3); c1[4] = CAND(1, 4); c1[5] = CAND(1, 5); c1[6] = CAND(1, 6); c1[7] = CAND(1, 7);
          c1[8] = CAND(2, 0); c1[9] = CAND(2, 1); c1[10] = CAND(2, 2); c1[11] = CAND(2, 3); c1[12] = CAND(2, 4); c1[13] = CAND(3, 0); c1[14] = CAND(3, 1); c1[15] = CAND(3, 2);
          c2[0] = CAND(3, 3); c2[1] = CAND(4, 0); c2[2] = CAND(4, 1); c2[3] = CAND(4, 2); c2[4] = CAND(5, 0); c2[5] = CAND(5, 1); c2[6] = CAND(6, 0); c2[7] = CAND(6, 1);
          c2[8] = CAND(7, 0); c2[9] = CAND(7, 1); c2[10] = CAND(8, 0); c2[11] = CAND(9, 0); c2[12] = CAND(10, 0); c2[13] = CAND(11, 0); c2[14] = CAND(12, 0); c2[15] = CAND(13, 0);
          c3[0] = CAND(14, 0); c3[1] = CAND(15, 0);
#pragma unroll
          for (int i = 2; i < 16; ++i) c3[i] = NEGI;
#undef CAND
        }
        sort16_desc(c0); sort16_desc(c1); sort16_desc(c2); sort16_desc(c3); merge16_desc(c0, c1); merge16_desc(c2, c3); merge16_desc(c0, c2);
        float e[16], z = 0.f;
#pragma unroll
        for (int i = 0; i < 16; ++i) { e[i] = __expf(c0[i] - c0[0]); z += e[i]; }
        const float iz = 1.0f / z;
        LDS_WAIT();
#pragma unroll
        for (int k = 0; k < 8; ++k) { const float cv = hi ? c0[k + 8] : c0[k]; const float ev = hi ? e[k + 8] : e[k]; const unsigned bits = __float_as_uint(cv);
            const unsigned ia = ibuf[(bits >> 4) & 15u], ib = ibuf[16 + (bits & 15u)];
            const size_t o = (size_t)tok * 128 + h * 16 + k + 8 * hi; IDS[o] = (int)(ia * 128u + ib); GT[o] = ev * iz; }
        LDS_WAIT();
    }
}
__device__ __forceinline__ float dot2u(unsigned a, unsigned b, float acc) { return __builtin_amdgcn_fdot2_f32_bf16(__builtin_bit_cast(bf16x2_t, a), __builtin_bit_cast(bf16x2_t, b), acc, false); }
__device__ __forceinline__ float dot8(const v4u h, const v4u u, float acc) {
    const unsigned hx = h.x, hy = h.y, hz = h.z, hw = h.w, ux = u.x, uy = u.y, uz = u.z, uw = u.w;
    acc = dot2u(hx, ux, acc); acc = dot2u(hy, uy, acc); acc = dot2u(hz, uz, acc); acc = dot2u(hw, uw, acc);
    return acc;
}
__device__ __forceinline__ float gelu_tanh(float x) {
    const float y = 0.7978845608028654f * (x + 0.044715f * x * x * x);
    const float e = __builtin_amdgcn_exp2f(2.0f * 1.4426950408889634f * y);
    const float th = 1.0f - 2.0f * __builtin_amdgcn_rcpf(e + 1.0f);
    return 0.5f * x * (1.0f + th);
}

__device__ __forceinline__ void peer_phase(Frame& F, const Args& A, int l) {
    const int gw = F.vcu * NWAVES + F.wave, NGW = F.G * NWAVES, lane = F.lane;
    const bf16* U = (const bf16*)(A.ws + WS_U) + (size_t)l * NEXP * DM; const bf16* V = (const bf16*)(A.ws + WS_V) + (size_t)l * NEXP * DM;
    const bf16* H = (const bf16*)(A.ws + WS_H); bf16* Hn = (bf16*)(A.ws + WS_H);
    const int* IDS = (const int*)(A.ws + WS_IDS); const float* GT = (const float*)(A.ws + WS_GATES);
    const float* mod = (const float*)(A.ws + WS_MOD);
    for (int tk = gw; tk < M; tk += NGW) {
        const int b = tk / SEQ;
        const v4u h0 = *(const GAS v4u*)(H + (size_t)tk * DM + 8 * lane), h1 = *(const GAS v4u*)(H + (size_t)tk * DM + 512 + 8 * lane);
        float outv[16];
#pragma unroll
        for (int i = 0; i < 16; ++i) outv[i] = 0.f;
#pragma unroll 1
        for (int jb = 0; jb < 2; ++jb) {
            const int idv = IDS[(size_t)tk * 128 + jb * 64 + lane]; const float gtv = GT[(size_t)tk * 128 + jb * 64 + lane];
            float p[64];
#pragma unroll
            for (int e = 0; e < 64; ++e) { const int id = __builtin_amdgcn_readlane(idv, e); const bf16* ur = U + (size_t)id * DM + 8 * lane;
                const v4u u0 = *(const GAS v4u*)ur, u1 = *(const GAS v4u*)(ur + 512); p[e] = dot8(h1, u1, dot8(h0, u0, 0.f)); }
#pragma unroll
            for (int i = 0; i < 32; ++i) { auto rr = __builtin_amdgcn_permlane32_swap(__float_as_uint(p[i]), __float_as_uint(p[i + 32]), false, false); p[i] = __uint_as_float(rr[0]) + __uint_as_float(rr[1]); }
#pragma unroll
            for (int w = 16; w >= 1; w >>= 1) { const bool up = (lane & w) != 0;
#pragma unroll
                for (int i = 0; i < w; ++i) { const float keep = up ? p[i + w] : p[i], send = up ? p[i] : p[i + w]; p[i] = keep + __shfl_xor(send, w); } }
            const float s = gtv * gelu_tanh(p[0]);
#pragma unroll 8
            for (int e = 0; e < 64; ++e) { const int id = __builtin_amdgcn_readlane(idv, e); const float se = __uint_as_float(__builtin_amdgcn_readlane(__float_as_uint(s), e)); const bf16* vr = V + (size_t)id * DM + 8 * lane;
                const v4u v0 = *(const GAS v4u*)vr, v1 = *(const GAS v4u*)(vr + 512);
                outv[0] += se * bflo(v0.x); outv[1] += se * bfhi(v0.x); outv[2] += se * bflo(v0.y); outv[3] += se * bfhi(v0.y); outv[4] += se * bflo(v0.z); outv[5] += se * bfhi(v0.z); outv[6] += se * bflo(v0.w); outv[7] += se * bfhi(v0.w);
                outv[8] += se * bflo(v1.x); outv[9] += se * bfhi(v1.x); outv[10] += se * bflo(v1.y); outv[11] += se * bfhi(v1.y); outv[12] += se * bflo(v1.z); outv[13] += se * bfhi(v1.z); outv[14] += se * bflo(v1.w); outv[15] += se * bfhi(v1.w); }
        }
#ifdef DBG_CHECK
        if (l == 0 && (tk & 63) == 0) { float* fb = (float*)(A.ws + WS_DBG) + (size_t)(4 << 20) + (size_t)(tk >> 6) * DM;
#pragma unroll
            for (int i = 0; i < 8; ++i) { fb[8 * lane + i] = outv[i]; fb[512 + 8 * lane + i] = outv[8 + i]; } }
#endif
#ifdef DBG_SKIP_PEER
#pragma unroll
        for (int i = 0; i < 16; ++i) outv[i] = 0.f;
#endif
        float* xr = A.out + (size_t)tk * DM; const float* g2 = mod + ((size_t)l * NB + b) * 6 * DM + 5 * DM;
        float xv[16]; float ss = 0.f;
#pragma unroll
        for (int j = 0; j < 2; ++j)
#pragma unroll
            for (int q = 0; q < 2; ++q) { const int c = 512 * j + 8 * lane + 4 * q; const f32x4 x4 = *(const GAS f32x4*)(xr + c), g4 = *(const f32x4*)(g2 + c);
#pragma unroll
                for (int i = 0; i < 4; ++i) { const float v = x4[i] + g4[i] * outv[8 * j + 4 * q + i]; xv[8 * j + 4 * q + i] = v; ss += v * v; } }
        const float r = 1.0f / sqrtf(wave_sum(ss) * (1.0f / DM) + NORM_EPS);
        if (l == DEPTH - 1) {
            const float* fg = A.in[20];
#pragma unroll
            for (int j = 0; j < 2; ++j)
#pragma unroll
                for (int q = 0; q < 2; ++q) { const int c = 512 * j + 8 * lane + 4 * q; const f32x4 g4 = *(const f32x4*)(fg + c); f32x4 o;
#pragma unroll
                    for (int i = 0; i < 4; ++i) o[i] = xv[8 * j + 4 * q + i] * r * g4[i];
                    *(GAS f32x4*)(xr + c) = o; }
        } else {
            const float* ng = A.in[4] + (size_t)(l + 1) * DM; const float* mn = mod + ((size_t)(l + 1) * NB + b) * 6 * DM;
#pragma unroll
            for (int j = 0; j < 2; ++j) { float y[8];
#pragma unroll
                for (int q = 0; q < 2; ++q) { const int c = 512 * j + 8 * lane + 4 * q; const f32x4 g4 = *(const f32x4*)(ng + c), sc4 = *(const f32x4*)(mn + DM + c), sh4 = *(const f32x4*)(mn + c); f32x4 x4;
#pragma unroll
                    for (int i = 0; i < 4; ++i) { x4[i] = xv[8 * j + 4 * q + i]; y[4 * q + i] = x4[i] * r * g4[i] * (1.0f + sc4[i]) + sh4[i]; }
                    *(GAS f32x4*)(xr + c) = x4; }
                v4u w; w.x = pk2(y[0], y[1]); w.y = pk2(y[2], y[3]); w.z = pk2(y[4], y[5]); w.w = pk2(y[6], y[7]);
                *(GAS v4u*)(Hn + (size_t)tk * DM + 512 * j + 8 * lane) = w; }
        }
    }
}
__global__ void __launch_bounds__(NWAVES * 64, 2) hybrid_fwd(Args args) {
    extern __shared__ __attribute__((aligned(16))) unsigned char lds[];
    Frame F;
    F.lds = (LAS unsigned char*)lds; F.ldsg = lds;
    F.tid = threadIdx.x; F.lane = F.tid & 63; F.wave = __builtin_amdgcn_readfirstlane(F.tid >> 6);
    F.G = gridDim.x; { const int bx = blockIdx.x; F.vcu = (F.G % 8 == 0) ? (bx % 8) * (F.G / 8) + bx / 8 : bx; }
    volatile LAS unsigned* MISC = (volatile LAS unsigned*)(F.lds + MISC_OFF);
    for (int u = F.tid; u < (LDS_BYTES - LDSCTL_OFF) / 4; u += NWAVES * 64) ((LAS unsigned*)(F.lds + LDSCTL_OFF))[u] = 0u;
    __syncthreads();
    XcdBarrier bar = xcd_barrier_post((unsigned*)(args.ws + WS_CTL) + CW_BAR, MISC + 8);
    const int lo = args.ph_lo, hi = args.ph_hi;
#ifndef TESTPH
#define TESTPH -1
#endif
#define PHON(k) (TESTPH < 0 || TESTPH == (k))
#define IN(k) (lo <= (k) && (k) < hi)
#define SEAM(k) do { if ((k) + 1 < hi) xcd_barrier(bar); } while (0)
#define RELANE() do { int t_ = threadIdx.x; asm volatile("" : "+v"(t_)); F.tid = t_; F.lane = t_ & 63; F.wave = __builtin_amdgcn_readfirstlane(t_ >> 6); } while (0)
    if (PHON(100) && IN(PH_PRO_A)) { RELANE(); prologue_a(F, args); SEAM(PH_PRO_A); }
    if (PHON(101) && IN(PH_PRO_B)) { RELANE(); prologue_b(F, args); SEAM(PH_PRO_B); }
    bf16* Hb = (bf16*)(args.ws + WS_H); bf16* PROJ = (bf16*)(args.ws + WS_PROJ);
#pragma unroll 1
    for (int l = 0; l < DEPTH; ++l) {
        const int base = PH_LAYER0 + l * PH_PER_LAYER;
        if (base + PH_PER_LAYER <= lo || base >= hi) continue;
        if (PHON(0) && IN(base + 0)) {
            pg8::Gemm g{Hb, (const bf16*)(args.ws + WS_WIN) + (size_t)l * INW * DM, M, INW, DM}; pg8::StaticOrder S; S.init(M, INW, F.G, (int)blockIdx.x);
            pg8::EpiProj E{PROJ, INW, attn_body::C2};
            pg8::gemm_phase<pg8::EpiProj, pg8::StaticOrder, true, true>(F.lds, g, S, E);
            SEAM(base + 0);
        }
        if (PHON(1) && IN(base + 1)) { RELANE(); attn_phase_all(F, args); SEAM(base + 1); }
        if (PHON(2) && IN(base + 2)) { RELANE(); combine_phase(F, args, l); SEAM(base + 2); }
        if (PHON(3) && IN(base + 3)) {
            { pg8::Gemm g{(const bf16*)(args.ws + WS_OA), (const bf16*)(args.ws + WS_WPA) + (size_t)l * DM * 512, M, DM, 512}; pg8::StaticOrder S; S.init(M, DM, F.G, (int)blockIdx.x);
              pg8::EpiGateMulF32 E{(float*)(args.ws + WS_TMP), DM, PROJ + COL_GA, INW};
              pg8::gemm_phase<pg8::EpiGateMulF32, pg8::StaticOrder, true, true>(F.lds, g, S, E); }
            VM_WAIT(); __syncthreads();
            { pg8::Gemm g{(const bf16*)(args.ws + WS_OB), (const bf16*)(args.ws + WS_WPB) + (size_t)l * DM * DM, M, DM, DM}; pg8::StaticOrder S; S.init(M, DM, F.G, (int)blockIdx.x);
              pg8::EpiGateAddBf16 E{(bf16*)(args.ws + WS_MERGED), (const float*)(args.ws + WS_TMP), DM, PROJ + COL_GB, INW};
              pg8::gemm_phase<pg8::EpiGateAddBf16, pg8::StaticOrder, true, true>(F.lds, g, S, E); }
            SEAM(base + 3);
        }
        if (PHON(4) && IN(base + 4)) {
            pg8::Gemm g{(const bf16*)(args.ws + WS_MERGED), (const bf16*)(args.ws + WS_WO) + (size_t)l * DM * DM, M, DM, DM}; pg8::StaticOrder S; S.init(M, DM, F.G, (int)blockIdx.x);
            pg8::EpiResid E{args.out, DM, (const float*)(args.ws + WS_MOD) + (size_t)l * NB * 6 * DM + 2 * DM, 6 * DM, SEQ};
            pg8::gemm_phase<pg8::EpiResid, pg8::StaticOrder, true, true>(F.lds, g, S, E);
            SEAM(base + 4);
        }
        if (PHON(5) && IN(base + 5)) { RELANE(); norm2_phase(F, args, l); SEAM(base + 5); }
        if (PHON(6) && IN(base + 6)) {
            pg8::Gemm g{Hb, (const bf16*)(args.ws + WS_WQ) + (size_t)l * PQW * DM, M, PQW, DM}; pg8::StaticOrder S; S.init(M, PQW, F.G, (int)blockIdx.x);
            pg8::EpiBf16<0> E{(bf16*)(args.ws + WS_PQ), PQW, nullptr, 0, 0, 1.f};
            pg8::gemm_phase<pg8::EpiBf16<0>, pg8::StaticOrder, true, true>(F.lds, g, S, E);
            SEAM(base + 6);
        }
        if (PHON(7) && IN(base + 7)) { RELANE(); topk_phase(F, args, l); SEAM(base + 7); }
        if (PHON(8) && IN(base + 8)) { RELANE(); peer_phase(F, args, l); SEAM(base + 8); }
    }
#undef IN
#undef SEAM
}


#ifdef DBG_CHECK
__global__ void __launch_bounds__(256) dbg_k1(Args A, int l) {
    float* dw = (float*)(A.ws + WS_CTL) + 2048;
    const int g = blockIdx.x * 256 + threadIdx.x;
    const bf16* PQ = (const bf16*)(A.ws + WS_PQ); const bf16* SK = (const bf16*)(A.ws + WS_SUBK) + (size_t)l * 2 * 128 * 128;
    const int* IDS = (const int*)(A.ws + WS_IDS); const float* GT = (const float*)(A.ws + WS_GATES);
    if (g < 2048) {
        float* scr = (float*)(A.ws + WS_DBG) + (size_t)g * 512;
        const int tok = g * 8; float miss = 0.f, gerr = 0.f;
        for (int h = 0; h < 8; ++h) {
            for (int p = 0; p < 2; ++p)
                for (int k = 0; k < 128; ++k) { float s = 0.f;
                    for (int d = 0; d < 128; ++d) s += bflo((unsigned)PQ[(size_t)tok * PQW + h * 256 + p * 128 + d]) * bflo((unsigned)SK[(p * 128 + k) * 128 + d]);
                    scr[p * 128 + k] = s; }
            for (int p = 0; p < 2; ++p)
                for (int i = 0; i < 16; ++i) { float best = -INFINITY; int bi = 0;
                    for (int k = 0; k < 128; ++k) { const float v = scr[p * 128 + k]; if (v > best) { best = v; bi = k; } }
                    scr[256 + p * 32 + i] = best; scr[256 + p * 32 + 16 + i] = (float)bi; scr[p * 128 + bi] = -INFINITY; }
            for (int i = 0; i < 16; ++i) for (int j = 0; j < 16; ++j) scr[i * 16 + j] = scr[256 + i] + scr[256 + 32 + j];
            for (int i = 0; i < 16; ++i) { float best = -INFINITY; int bi = 0;
                for (int k = 0; k < 256; ++k) { const float v = scr[k]; if (v > best) { best = v; bi = k; } }
                scr[384 + i] = best; scr[400 + i] = (float)((int)scr[256 + 16 + (bi >> 4)] * 128 + (int)scr[256 + 32 + 16 + (bi & 15)]); scr[bi] = -INFINITY; }
            float z = 0.f; const float b0 = scr[384];
            for (int i = 0; i < 16; ++i) z += __expf(scr[384 + i] - b0);
            for (int i = 0; i < 16; ++i) { const float gi = __expf(scr[384 + i] - b0) / z; const int myid = (int)scr[400 + i]; bool found = false;
                for (int k = 0; k < 16; ++k) { if (IDS[(size_t)tok * 128 + h * 16 + k] == myid) { found = true; gerr += fabsf(GT[(size_t)tok * 128 + h * 16 + k] - gi); } }
                if (!found) miss += 1.f; }
        }
        atomicAdd(dw + 0, miss); atomicAdd(dw + 1, gerr);
    }
    __shared__ float red[256]; __shared__ float sdot;
    if (blockIdx.x < 256) {
        const int tk = blockIdx.x * 64, t = threadIdx.x; const bf16* H = (const bf16*)(A.ws + WS_H) + (size_t)tk * DM;
        const float* Uf = A.in[18] + (size_t)l * NEXP * DM; const float* Vf = A.in[19] + (size_t)l * NEXP * DM;
        float hf[4], on[4] = {0.f, 0.f, 0.f, 0.f};
        for (int i = 0; i < 4; ++i) hf[i] = bflo((unsigned)H[4 * t + i]);
        for (int e = 0; e < 128; ++e) { const int id = IDS[(size_t)tk * 128 + e]; const float gt = GT[(size_t)tk * 128 + e];
            float d = 0.f; for (int i = 0; i < 4; ++i) d += hf[i] * Uf[(size_t)id * DM + 4 * t + i];
            red[t] = d; __syncthreads();
            if (t == 0) { float s = 0.f; for (int i = 0; i < 256; ++i) s += red[i]; sdot = s; }
            __syncthreads();
            const float dd = sdot; const float act = 0.5f * dd * (1.0f + tanhf(0.7978845608028654f * (dd + 0.044715f * dd * dd * dd))); const float s = gt * act;
            for (int i = 0; i < 4; ++i) on[i] += s * Vf[(size_t)id * DM + 4 * t + i];
            __syncthreads(); }
        float* nb = (float*)(A.ws + WS_DBG) + (size_t)(5 << 20) + (size_t)blockIdx.x * DM;
        for (int i = 0; i < 4; ++i) nb[4 * t + i] = on[i];
    }
}
__global__ void __launch_bounds__(256) dbg_k2a(Args A) {
    float* dw = (float*)(A.ws + WS_CTL) + 2048;
    const float* fb = (const float*)(A.ws + WS_DBG) + (size_t)(4 << 20) + (size_t)blockIdx.x * DM; const float* nb = (const float*)(A.ws + WS_DBG) + (size_t)(5 << 20) + (size_t)blockIdx.x * DM;
    float num = 0.f, den = 0.f;
    for (int i = threadIdx.x; i < DM; i += 256) { const float d = fb[i] - nb[i]; num += d * d; den += nb[i] * nb[i]; }
    atomicAdd(dw + 2, num); atomicAdd(dw + 3, den);
}
__global__ void __launch_bounds__(256) dbg_k2b(Args A) {
    const float* dw = (const float*)(A.ws + WS_CTL) + 2048; float Dv;
    if (DBG_CHECK == 1) Dv = dw[0] * (1.0f / 262144.0f); else if (DBG_CHECK == 2) Dv = dw[1] * (1.0f / 262144.0f); else Dv = sqrtf(dw[2] / fmaxf(dw[3], 1e-30f));
    const float al = 1.0f + 100.0f * Dv;
    for (size_t i = (size_t)blockIdx.x * 256 + threadIdx.x; i < (size_t)M * DM; i += (size_t)gridDim.x * 256) A.out[i] *= al;
}
#endif
extern "C" void kernel_launch(void* const* d_in, const int* in_sizes, int n_in, void* d_out, int out_size, void* d_ws, size_t ws_size, hipStream_t stream) {
    static int grid = 0;
    if (grid == 0) {
        if (n_in != 21 || out_size != M * DM || ws_size < WS_END) { fprintf(stderr, "kernel_launch: unexpected problem (n_in %d, out %d, ws %zu)\n", n_in, out_size, ws_size); grid = -1; return; }
        int dev = 0, cus = 0, per_cu = 0;
        if (hipGetDevice(&dev) != hipSuccess || hipDeviceGetAttribute(&cus, hipDeviceAttributeMultiprocessorCount, dev) != hipSuccess) { grid = -1; return; }
        if (hipFuncSetAttribute((const void*)hybrid_fwd, hipFuncAttributeMaxDynamicSharedMemorySize, LDS_BYTES) != hipSuccess) { fprintf(stderr, "kernel_launch: hipFuncSetAttribute failed\n"); grid = -1; return; }
        if (hipOccupancyMaxActiveBlocksPerMultiprocessor(&per_cu, (const void*)hybrid_fwd, NWAVES * 64, LDS_BYTES) != hipSuccess || per_cu < 1) fprintf(stderr, "kernel_launch: occupancy query reports %d\n", per_cu);
        (void)hipGetLastError();
        grid = cus;
    }
    if (grid < 0) return;
    (void)hipMemsetAsync((char*)d_ws + WS_CTL, 0, CTL_ZERO_BYTES, stream);
    Args a{};
    for (int i = 0; i < 21; ++i) a.in[i] = (const float*)d_in[i];
    a.out = (float*)d_out; a.ws = (unsigned char*)d_ws;
#if MK_PER_PHASE
    for (int p = 0; p < NPHASE; ++p) { a.ph_lo = p; a.ph_hi = p + 1;
#ifdef DBG_CHECK
        if (p == PH_LAYER0 + 8) hipLaunchKernelGGL(dbg_k1, dim3(256), dim3(256), 0, stream, a, 0);
#endif
        hipLaunchKernelGGL(hybrid_fwd, dim3(grid), dim3(NWAVES * 64), LDS_BYTES, stream, a); }
#ifdef DBG_CHECK
    hipLaunchKernelGGL(dbg_k2a, dim3(256), dim3(256), 0, stream, a);
    hipLaunchKernelGGL(dbg_k2b, dim3(1024), dim3(256), 0, stream, a);
#endif
#else
    a.ph_lo = 0; a.ph_hi = NPHASE;
    hipLaunchKernelGGL(hybrid_fwd, dim3(grid), dim3(NWAVES * 64), LDS_BYTES, stream, a);
#endif
}
```

```cpp
#include <hip/hip_runtime.h>
#include <hip/hip_bf16.h>
#include <cstdio>
#include <cstdint>
#include <cmath>
#ifndef MK_PER_PHASE
#define MK_PER_PHASE 0
#endif
namespace pg8 {
#define PG8_LAS __attribute__((address_space(3)))
typedef unsigned short bf16_t;
typedef short bf16x8 __attribute__((ext_vector_type(8)));
typedef float f32x4 __attribute__((ext_vector_type(4)));
typedef unsigned u32x4 __attribute__((ext_vector_type(4)));
constexpr int BM = 256, BK = 64, HALF = 128, HTB = HALF * BK * 2  , STAGE_BYTES = 8 * HTB, NXCD = 8, WGM = 8;

__host__ __device__ __forceinline__ int lds_byte(int r, int c) { const int st = (r >> 4) * 2 + (c >> 5), rr = r & 15, cc = c & 31, ob = rr * 64 + cc * 2; return st * 1024 + (ob ^ (((ob >> 9) & 1) << 5)); }
__host__ __device__ __forceinline__ void stage_rc(int b, int& R, int& C) { const int st = b / 1024, sb = b % 1024, swz = sb ^ (((sb >> 9) & 1) << 5); R = (st >> 1) * 16 + swz / 64; C = (st & 1) * 32 + (swz % 64) / 2; }
__host__ __device__ __forceinline__ int perm32(int rho) { const int n = rho >> 4, i = rho & 15; return 8 * (i >> 2) + 4 * n + (i & 3); }

struct Unit { int pm, pn; };
struct Gemm { const bf16_t* A; const bf16_t* Bt; int M, N, K; };

struct StaticOrder {
    int nM, nN, nwg, G, c;
    __host__ __device__ void init(int M, int N, int G_, int c_) { nM = M / BM; nN = N / BM; nwg = nM * nN; G = G_; c = c_; }
    __host__ __device__ bool next(int i, Unit& u) const {
        const long L = (long)i * G + c; if (L >= nwg) return false;
        int wgid = (int)L; { const int q = nwg / NXCD, r = nwg % NXCD, xcd = wgid % NXCD, off = wgid / NXCD; wgid = (xcd < r ? xcd * (q + 1) : r * (q + 1) + (xcd - r) * q) + off; }
        const int nig = WGM * nN, gid = wgid / nig, fm = gid * WGM, gsz = (nM - fm) < WGM ? (nM - fm) : WGM;
        u.pm = fm + ((wgid % nig) % gsz); u.pn = (wgid % nig) / gsz; return true;
    }
    __device__ __forceinline__ void a_ready(const Unit&) const {}
    __device__ __forceinline__ void done(const Unit&) const {}
};

__device__ __forceinline__ unsigned cvt_pk_bf16(float lo, float hi) { unsigned r; asm volatile("v_cvt_pk_bf16_f32 %0, %1, %2" : "=v"(r) : "v"(lo), "v"(hi)); return r; }
typedef float f32x2 __attribute__((ext_vector_type(2)));
__device__ __forceinline__ f32x2 gelu_pk(f32x2 v) {
    const f32x2 av = __builtin_elementwise_abs(v), d = av * 0.2316418882f + 1.0f;
    f32x2 t; t.x = __builtin_amdgcn_rcpf(d.x); t.y = __builtin_amdgcn_rcpf(d.y);
    f32x2 q = t * 0.5307027145f + (-0.7265760135f); q = q * t + 0.7107068705f; q = q * t + (-0.142248368f); q = q * t + 0.127414796f; q = q * t;
    const f32x2 s = (v * v) * (-0.72134752044f);
    f32x2 e; e.x = __builtin_amdgcn_exp2f(s.x); e.y = __builtin_amdgcn_exp2f(s.y);
    const f32x2 m = v * (q * e), r = v - m;
    f32x2 o; o.x = v.x < 0.f ? m.x : r.x; o.y = v.y < 0.f ? m.y : r.y; return o;
}

template <int ACT  > struct EpiBf16 {
    static constexpr bool PERM = true, AFTER_DRAIN = false; static_assert(ACT == 0 || ACT == 1, "EpiBf16: ACT is 0 (none) or 1 (gelu_pk)");
    bf16_t* O; int ldc; const float* bias; int split_cols; size_t split_stride; float scale0;
    __device__ __forceinline__ void operator()(const f32x4 (&acc)[2][2][4][2], const Unit& u, int wr, int wc, int fr, int fq) const {
        const int row0 = u.pm * BM + wr * 64 + fr; int colt = u.pn * BM; bf16_t* base = O;
        float sc = 1.f; if (split_cols) { const int t = colt / split_cols; base += (size_t)t * split_stride; colt -= t * split_cols; if (t == 0) sc = scale0; }
        const int col0 = colt + wc * 32 + 8 * fq, bcol0 = u.pn * BM + wc * 32 + 8 * fq;
        f32x4 bv[2][2];
#pragma unroll
        for (int bj = 0; bj < 2; ++bj)
#pragma unroll
            for (int n = 0; n < 2; ++n) bv[bj][n] = bias ? *(const f32x4*)(bias + bcol0 + bj * HALF + 4 * n) : (f32x4){0.f, 0.f, 0.f, 0.f};
#pragma unroll
        for (int ai = 0; ai < 2; ++ai)
#pragma unroll
            for (int m = 0; m < 4; ++m) { bf16_t* rowp = base + (size_t)(row0 + ai * HALF + m * 16) * ldc + col0;
#pragma unroll
                for (int bj = 0; bj < 2; ++bj) { f32x4 v0 = acc[ai][bj][m][0] + bv[bj][0], v1 = acc[ai][bj][m][1] + bv[bj][1];
                    if (ACT == 1) { f32x2 a = gelu_pk((f32x2){v0[0], v0[1]}), b = gelu_pk((f32x2){v0[2], v0[3]}), c = gelu_pk((f32x2){v1[0], v1[1]}), d = gelu_pk((f32x2){v1[2], v1[3]});
                        v0 = (f32x4){a.x, a.y, b.x, b.y}; v1 = (f32x4){c.x, c.y, d.x, d.y}; }
                    v0 = v0 * sc; v1 = v1 * sc; u32x4 w; w.x = cvt_pk_bf16(v0[0], v0[1]); w.y = cvt_pk_bf16(v0[2], v0[3]); w.z = cvt_pk_bf16(v1[0], v1[1]); w.w = cvt_pk_bf16(v1[2], v1[3]);
                    *(u32x4*)(rowp + bj * HALF) = w; } }
    }
};
typedef unsigned u32x2 __attribute__((ext_vector_type(2)));
__device__ __forceinline__ float bf_lo(unsigned w) { return __uint_as_float(w << 16); }
__device__ __forceinline__ float bf_hi(unsigned w) { return __uint_as_float(w & 0xffff0000u); }
__device__ __forceinline__ float sigmoidf_fast(float v) { return __builtin_amdgcn_rcpf(1.0f + __builtin_amdgcn_exp2f(-1.4426950408889634f * v)); }
struct EpiProj {
    static constexpr bool PERM = true, AFTER_DRAIN = false;
    bf16_t* O; int ldc; float c2;
    __device__ __forceinline__ void operator()(const f32x4 (&acc)[2][2][4][2], const Unit& u, int wr, int wc, int fr, int fq) const {
        const int row0 = u.pm * BM + wr * 64 + fr, col0 = u.pn * BM + wc * 32 + 8 * fq;
        const bool isq = (u.pn < 6) || (u.pn >= 18 && u.pn < 22), isg = (u.pn >= 30);
        const float sc = isq ? c2 : 1.0f;
#pragma unroll
        for (int ai = 0; ai < 2; ++ai)
#pragma unroll
            for (int m = 0; m < 4; ++m) { bf16_t* rowp = O + (size_t)(row0 + ai * HALF + m * 16) * ldc + col0;
#pragma unroll
                for (int bj = 0; bj < 2; ++bj) { f32x4 v0 = acc[ai][bj][m][0], v1 = acc[ai][bj][m][1];
                    if (isg) { v0 = (f32x4){sigmoidf_fast(v0[0]), sigmoidf_fast(v0[1]), sigmoidf_fast(v0[2]), sigmoidf_fast(v0[3])}; v1 = (f32x4){sigmoidf_fast(v1[0]), sigmoidf_fast(v1[1]), sigmoidf_fast(v1[2]), sigmoidf_fast(v1[3])}; }
                    else { v0 = v0 * sc; v1 = v1 * sc; }
                    u32x4 w; w.x = cvt_pk_bf16(v0[0], v0[1]); w.y = cvt_pk_bf16(v0[2], v0[3]); w.z = cvt_pk_bf16(v1[0], v1[1]); w.w = cvt_pk_bf16(v1[2], v1[3]);
                    *(u32x4*)(rowp + bj * HALF) = w; } }
    }
};
struct EpiGateMulF32 {
    static constexpr bool PERM = true, AFTER_DRAIN = false;
    float* T; int ldc; const bf16_t* G; int ldg;
    __device__ __forceinline__ void operator()(const f32x4 (&acc)[2][2][4][2], const Unit& u, int wr, int wc, int fr, int fq) const {
        const int row0 = u.pm * BM + wr * 64 + fr, col0 = u.pn * BM + wc * 32 + 8 * fq;
#pragma unroll
        for (int ai = 0; ai < 2; ++ai)
#pragma unroll
            for (int m = 0; m < 4; ++m) { const size_t row = (size_t)(row0 + ai * HALF + m * 16);
#pragma unroll
                for (int bj = 0; bj < 2; ++bj) { const int c = col0 + bj * HALF; const u32x4 g = *(const u32x4*)(G + row * ldg + c);
                    f32x4 v0 = acc[ai][bj][m][0], v1 = acc[ai][bj][m][1];
                    v0 = v0 * (f32x4){bf_lo(g.x), bf_hi(g.x), bf_lo(g.y), bf_hi(g.y)}; v1 = v1 * (f32x4){bf_lo(g.z), bf_hi(g.z), bf_lo(g.w), bf_hi(g.w)};
                    *(f32x4*)(T + row * ldc + c) = v0; *(f32x4*)(T + row * ldc + c + 4) = v1; } }
    }
};
struct EpiGateAddBf16 {
    static constexpr bool PERM = true, AFTER_DRAIN = false;
    bf16_t* O; const float* T; int ldc; const bf16_t* G; int ldg;
    __device__ __forceinline__ void operator()(const f32x4 (&acc)[2][2][4][2], const Unit& u, int wr, int wc, int fr, int fq) const {
        const int row0 = u.pm * BM + wr * 64 + fr, col0 = u.pn * BM + wc * 32 + 8 * fq;
#pragma unroll
        for (int ai = 0; ai < 2; ++ai)
#pragma unroll
            for (int m = 0; m < 4; ++m) { const size_t row = (size_t)(row0 + ai * HALF + m * 16);
#pragma unroll
                for (int bj = 0; bj < 2; ++bj) { const int c = col0 + bj * HALF; const u32x4 g = *(const u32x4*)(G + row * ldg + c);
                    const f32x4 t0 = *(const f32x4*)(T + row * ldc + c), t1 = *(const f32x4*)(T + row * ldc + c + 4);
                    f32x4 v0 = acc[ai][bj][m][0], v1 = acc[ai][bj][m][1];
                    v0 = t0 + v0 * (f32x4){bf_lo(g.x), bf_hi(g.x), bf_lo(g.y), bf_hi(g.y)}; v1 = t1 + v1 * (f32x4){bf_lo(g.z), bf_hi(g.z), bf_lo(g.w), bf_hi(g.w)};
                    u32x4 w; w.x = cvt_pk_bf16(v0[0], v0[1]); w.y = cvt_pk_bf16(v0[2], v0[3]); w.z = cvt_pk_bf16(v1[0], v1[1]); w.w = cvt_pk_bf16(v1[2], v1[3]);
                    *(u32x4*)(O + row * ldc + c) = w; } }
    }
};
struct EpiResid {
    static constexpr bool PERM = true, AFTER_DRAIN = false;
    float* X; int ldc; const float* gvec; int gstride; int rows_per_batch;
    __device__ __forceinline__ void operator()(const f32x4 (&acc)[2][2][4][2], const Unit& u, int wr, int wc, int fr, int fq) const {
        const int row0 = u.pm * BM + wr * 64 + fr, col0 = u.pn * BM + wc * 32 + 8 * fq;
        const float* gv = gvec + (size_t)((u.pm * BM) / rows_per_batch) * gstride;
        f32x4 g0[2], g1[2];
#pragma unroll
        for (int bj = 0; bj < 2; ++bj) { g0[bj] = *(const f32x4*)(gv + col0 + bj * HALF); g1[bj] = *(const f32x4*)(gv + col0 + bj * HALF + 4); }
#pragma unroll
        for (int ai = 0; ai < 2; ++ai)
#pragma unroll
            for (int m = 0; m < 4; ++m) { const size_t row = (size_t)(row0 + ai * HALF + m * 16);
#pragma unroll
                for (int bj = 0; bj < 2; ++bj) { float* p = X + row * ldc + col0 + bj * HALF;
                    const f32x4 x0 = *(const f32x4*)p, x1 = *(const f32x4*)(p + 4);
                    #ifdef DBG_SKIP_MIX
                    *(f32x4*)p = x0; *(f32x4*)(p + 4) = x1; } }
#else
                    *(f32x4*)p = x0 + g0[bj] * acc[ai][bj][m][0]; *(f32x4*)(p + 4) = x1 + g1[bj] * acc[ai][bj][m][1]; } }
#endif
    }
};
template <class Epi, class Sched, bool ALIGN_EPI = false, bool SP2 = false>
__device__ __forceinline__ void gemm_phase(PG8_LAS unsigned char* lds, const Gemm g, const Sched& S, const Epi& E) {
    int tid_ = threadIdx.x; asm volatile("" : "+v"(tid_));
    const int tid = tid_, wid = __builtin_amdgcn_readfirstlane(tid >> 6), lane = tid & 63, wr = wid >> 2, wc = wid & 3, fr = lane & 15, fq = lane >> 4;
    const int K = g.K, nt = K / BK;
    unsigned voffA[2], voffB[2];
#pragma unroll
    for (int i = 0; i < 2; ++i) { int R, C; stage_rc(tid * 16 + i * 8192, R, C); const int Rb = Epi::PERM ? ((R & ~31) + perm32(R & 31)) : R;
        voffA[i] = (unsigned)(R * K + C) * 2u; voffB[i] = (unsigned)(Rb * K + C) * 2u; }
    const size_t kstep = (size_t)(BK * 2);
    const size_t hstep = (size_t)HALF * K * 2;
    const size_t tstep = 2 * hstep;
    const unsigned ldsw = (unsigned)wid * 1024u;
    const int aoff = lds_byte(wr * 64 + fr, fq * 8), boff = lds_byte(wc * 32 + fr, fq * 8);
#define PG8_SA(b, h) (((b) * 2 + (h)) * HTB)
#define PG8_SB(b, h) ((4 + (b) * 2 + (h)) * HTB)
#define PG8_STAGE(bufoff, gbase, voff) do { _Pragma("unroll") for (int _i = 0; _i < 2; ++_i) \
        __builtin_amdgcn_global_load_lds((const unsigned*)((const char*)(gbase) + (voff)[_i]), (PG8_LAS unsigned*)(lds + (bufoff) + ldsw + _i * 8192), 16, 0, 0); } while (0)
#define PG8_LDA(dst, b, h) do { _Pragma("unroll") for (int m = 0; m < 4; ++m) _Pragma("unroll") for (int k = 0; k < 2; ++k) dst[m][k] = *(const PG8_LAS bf16x8*)(lds + PG8_SA(b, h) + aoff + m * 2048 + k * 1024); } while (0)
#define PG8_LDB(dst, b, h) do { _Pragma("unroll") for (int n = 0; n < 2; ++n) _Pragma("unroll") for (int k = 0; k < 2; ++k) dst[n][k] = *(const PG8_LAS bf16x8*)(lds + PG8_SB(b, h) + boff + n * 2048 + k * 1024); } while (0)
#define PG8_MMA(ai, bj, At, Bt) do { __builtin_amdgcn_s_setprio(1); _Pragma("unroll") for (int m = 0; m < 4; ++m) _Pragma("unroll") for (int n = 0; n < 2; ++n) _Pragma("unroll") for (int k = 0; k < 2; ++k) \
        acc[ai][bj][m][n] = __builtin_amdgcn_mfma_f32_16x16x32_bf16(Bt[n][k], At[m][k], acc[ai][bj][m][n], 0, 0, 0); __builtin_amdgcn_s_setprio(0); } while (0)
#define PG8_WAIT_V(n) asm volatile("s_waitcnt vmcnt(" #n ")" ::: "memory")
#define PG8_WAIT_L(n) asm volatile("s_waitcnt lgkmcnt(" #n ")" ::: "memory")
#define PG8_BAR __builtin_amdgcn_s_barrier()
#define PG8_SCHED __builtin_amdgcn_sched_barrier(0)
    Unit cur, nxt; int ui = 0;
    if (!S.next(0, cur)) return;
    f32x4 acc[2][2][4][2];
#pragma unroll
    for (int a = 0; a < 2; ++a)
#pragma unroll
        for (int b = 0; b < 2; ++b)
#pragma unroll
            for (int m = 0; m < 4; ++m)
#pragma unroll
                for (int n = 0; n < 2; ++n) acc[a][b][m][n] = (f32x4){0.f, 0.f, 0.f, 0.f};
    bf16x8 At[4][2], B0[2][2], B1[2][2];
    const char* cA = (const char*)g.A + (size_t)cur.pm * tstep; const char* cB = (const char*)g.Bt + (size_t)cur.pn * tstep;
    S.a_ready(cur);
    if constexpr (SP2) {
        PG8_STAGE(PG8_SB(0, 0), cB, voffB); PG8_STAGE(PG8_SB(0, 1), cB + hstep, voffB); PG8_STAGE(PG8_SA(0, 0), cA, voffA); PG8_STAGE(PG8_SA(0, 1), cA + hstep, voffA);
        if (wr == 1) PG8_BAR;
        PG8_WAIT_V(2); PG8_BAR;
        PG8_STAGE(PG8_SB(1, 0), cB + kstep, voffB); PG8_STAGE(PG8_SA(1, 0), cA + kstep, voffA); PG8_STAGE(PG8_SB(1, 1), cB + hstep + kstep, voffB);
        PG8_WAIT_V(6); PG8_BAR;
    } else {
        PG8_STAGE(PG8_SB(0, 0), cB, voffB); PG8_STAGE(PG8_SA(0, 0), cA, voffA); PG8_STAGE(PG8_SB(0, 1), cB + hstep, voffB); PG8_STAGE(PG8_SA(0, 1), cA + hstep, voffA);
        if (wr == 1) PG8_BAR;
        PG8_WAIT_V(4); PG8_BAR;
        PG8_STAGE(PG8_SB(1, 0), cB + kstep, voffB); PG8_STAGE(PG8_SA(1, 0), cA + kstep, voffA); PG8_STAGE(PG8_SB(1, 1), cB + hstep + kstep, voffB);
        PG8_WAIT_V(6); PG8_BAR;
    }
    for (;;) {
        const bool has_next = S.next(ui + 1, nxt);
        const char* nA = has_next ? (const char*)g.A + (size_t)nxt.pm * tstep : cA; const char* nB = has_next ? (const char*)g.Bt + (size_t)nxt.pn * tstep : cB;
        for (int t = 0; t < nt; t += 2) {
            const bool last = (t == nt - 2);
            const char* a1 = cA + (size_t)(t + 1) * kstep;
            const char* a2 = last ? nA : cA + (size_t)(t + 2) * kstep; const char* b2 = last ? nB : cB + (size_t)(t + 2) * kstep;
            const char* a3 = a2 + kstep; const char* b3 = b2 + kstep;
            if (last && has_next) S.a_ready(nxt);
            if constexpr (SP2) {
            PG8_LDB(B0, 0, 0); PG8_LDB(B1, 0, 1); PG8_SCHED; PG8_LDA(At, 0, 0); PG8_STAGE(PG8_SA(1, 1), a1 + hstep, voffA);
            PG8_WAIT_V(8); PG8_WAIT_L(0); PG8_BAR; PG8_MMA(0, 0, At, B0); PG8_MMA(0, 1, At, B1); PG8_BAR; PG8_SCHED;
            PG8_LDA(At, 0, 1); PG8_STAGE(PG8_SB(0, 0), b2, voffB); PG8_STAGE(PG8_SB(0, 1), b2 + hstep, voffB); PG8_STAGE(PG8_SA(0, 0), a2, voffA);
            PG8_WAIT_V(8); PG8_WAIT_L(0); PG8_BAR; PG8_MMA(1, 0, At, B0); PG8_MMA(1, 1, At, B1); PG8_BAR; PG8_SCHED;
            PG8_LDB(B0, 1, 0); PG8_LDB(B1, 1, 1); PG8_SCHED; PG8_LDA(At, 1, 0); PG8_STAGE(PG8_SA(0, 1), a2 + hstep, voffA);
            PG8_WAIT_V(8); PG8_WAIT_L(0); PG8_BAR; PG8_MMA(0, 0, At, B0); PG8_MMA(0, 1, At, B1); PG8_BAR; PG8_SCHED;
            PG8_LDA(At, 1, 1); PG8_STAGE(PG8_SB(1, 0), b3, voffB); PG8_STAGE(PG8_SB(1, 1), b3 + hstep, voffB); PG8_STAGE(PG8_SA(1, 0), a3, voffA);
            PG8_WAIT_V(8); PG8_WAIT_L(0); PG8_BAR; PG8_MMA(1, 0, At, B0); PG8_MMA(1, 1, At, B1); PG8_BAR; PG8_SCHED;
            } else {
            PG8_LDB(B0, 0, 0); PG8_SCHED; PG8_LDA(At, 0, 0); PG8_STAGE(PG8_SA(1, 1), a1 + hstep, voffA);
            PG8_WAIT_L(8); PG8_BAR; PG8_WAIT_L(0); PG8_MMA(0, 0, At, B0); PG8_BAR; PG8_SCHED;
            PG8_LDB(B1, 0, 1); PG8_STAGE(PG8_SB(0, 0), b2, voffB);
            PG8_BAR; PG8_WAIT_L(0); PG8_MMA(0, 1, At, B1); PG8_BAR;
            PG8_LDA(At, 0, 1); PG8_STAGE(PG8_SA(0, 0), a2, voffA);
            PG8_BAR; PG8_WAIT_L(0); PG8_MMA(1, 0, At, B0); PG8_BAR; PG8_SCHED;
            PG8_STAGE(PG8_SB(0, 1), b2 + hstep, voffB);
            PG8_WAIT_V(6); PG8_BAR; PG8_MMA(1, 1, At, B1); PG8_BAR;
            PG8_LDB(B0, 1, 0); PG8_SCHED; PG8_LDA(At, 1, 0); PG8_STAGE(PG8_SA(0, 1), a2 + hstep, voffA);
            PG8_WAIT_L(8); PG8_BAR; PG8_WAIT_L(0); PG8_MMA(0, 0, At, B0); PG8_BAR; PG8_SCHED;
            PG8_LDB(B1, 1, 1); PG8_STAGE(PG8_SB(1, 0), b3, voffB);
            PG8_BAR; PG8_WAIT_L(0); PG8_MMA(0, 1, At, B1); PG8_BAR;
            PG8_LDA(At, 1, 1); PG8_STAGE(PG8_SA(1, 0), a3, voffA);
            PG8_BAR; PG8_WAIT_L(0); PG8_MMA(1, 0, At, B0); PG8_BAR; PG8_SCHED;
            PG8_STAGE(PG8_SB(1, 1), b3 + hstep, voffB);
            PG8_WAIT_V(6); PG8_BAR; PG8_MMA(1, 1, At, B1); PG8_BAR;
            }
        }
        if constexpr (ALIGN_EPI) { if (wr == 0) PG8_BAR; }
        if constexpr (!Epi::AFTER_DRAIN) { E(acc, cur, wr, wc, fr, fq); S.done(cur); }
        if (!has_next) break;
#pragma unroll
        for (int a = 0; a < 2; ++a)
#pragma unroll
            for (int b = 0; b < 2; ++b)
#pragma unroll
                for (int m = 0; m < 4; ++m)
#pragma unroll
                    for (int n = 0; n < 2; ++n) acc[a][b][m][n] = (f32x4){0.f, 0.f, 0.f, 0.f};
        cur = nxt; cA = nA; cB = nB; ++ui;
        if constexpr (ALIGN_EPI) { if (wr == 1) PG8_BAR; }
    }
    PG8_WAIT_V(0);
    if constexpr (!ALIGN_EPI) { if (wr == 0) PG8_BAR; }
    PG8_BAR;
    if constexpr (Epi::AFTER_DRAIN) { E.fused(acc, cur, wr, wc, fr, fq, lds, wid, lane); S.done(cur); }
#undef PG8_SA
#undef PG8_SB
#undef PG8_STAGE
#undef PG8_LDA
#undef PG8_LDB
#undef PG8_MMA
#undef PG8_WAIT_V
#undef PG8_WAIT_L
#undef PG8_BAR
#undef PG8_SCHED
}
}
#include <hip/hip_bf16.h>
namespace attn_body {
using bf16=__hip_bfloat16;
using bf16x8=__attribute__((ext_vector_type(8)))short;
using s16x4=__attribute__((ext_vector_type(4)))short;
using f32x16=__attribute__((ext_vector_type(16)))float;
using u32x4=__attribute__((ext_vector_type(4)))unsigned;
constexpr int D=64;
constexpr int NW=8,QBLK=32,QB=QBLK*NW,KVBLK=64;
__device__ __forceinline__ int crow(int r,int hi){return (r&3)+8*(r>>2)+4*hi;}
#define SBAR() __builtin_amdgcn_sched_barrier(0)
__device__ __forceinline__ void cmask(f32x16&p0,f32x16&p1,int jb,int qrel,int hi){
  const float NEG=-INFINITY; int kb=64*jb+4*hi;
  #pragma unroll
  for(int r=0;r<16;++r){int kv=kb+(r&3)+8*(r>>2); if(kv>qrel)p0[r]=NEG; if(kv+32>qrel)p1[r]=NEG;}
}
__device__ __forceinline__ void wmask(f32x16&p0,f32x16&p1,int kb0,int qrel,int hi,int W,int PM){
  const float NEG=-INFINITY; const int d0=qrel-kb0-4*hi;
  #pragma unroll
  for(int r=0;r<16;++r){const int d=d0-((r&3)+8*(r>>2)); const int e=d-32;
    if(!(((unsigned)d<=(unsigned)W)&&((d&PM)==0)))p0[r]=NEG;
    if(!(((unsigned)e<=(unsigned)W)&&((e&PM)==0)))p1[r]=NEG;}
}
constexpr int NSLOT=3, SLOTB=8192;
constexpr int LDS_K=0, LDS_V=NSLOT*SLOTB, LDS_WS=2*NSLOT*SLOTB, LDS_OST=LDS_WS+NW*64*4, LDS_BIAS=LDS_OST+NW*4096, TBLN=2304, TPAD=256, LDS_BYTES=LDS_BIAS+TBLN*4;
constexpr float C2=0.125f*1.4426950408889634f;
__device__ __forceinline__ void glds16(const void*gsrc,unsigned lds_dst){unsigned keep;
  asm volatile("s_mov_b32 %0, m0\n\ts_mov_b32 m0, %2\n\ts_nop 0\n\tglobal_load_lds_dwordx4 %1, off\n\ts_mov_b32 m0, %0":"=&s"(keep):"v"(gsrc),"s"(lds_dst):"memory");}
__device__ __forceinline__ float max3f(float a,float b,float c){float r;asm("v_max3_f32 %0, %1, %2, %3":"=v"(r):"v"(a),"v"(b),"v"(c));return r;}
__device__ __forceinline__ float max2f(float a,float b){float r;asm("v_max_f32_e32 %0, %1, %2":"=v"(r):"v"(a),"v"(b));return r;}
__device__ __forceinline__ float fadd_s(float a,float b){float r;asm("v_add_f32_e32 %0, %1, %2":"=v"(r):"v"(a),"v"(b));return r;}
__device__ __forceinline__ float fsub_s(float a,float b){float r;asm("v_sub_f32_e32 %0, %1, %2":"=v"(r):"v"(a),"v"(b));return r;}
typedef float f32x2_t __attribute__((ext_vector_type(2))); typedef __bf16 bf16x2_t __attribute__((ext_vector_type(2)));
__device__ __forceinline__ unsigned cvtpk_s(float lo,float hi){f32x2_t v={lo,hi};bf16x2_t b=__builtin_convertvector(v,bf16x2_t);return __builtin_bit_cast(unsigned,b);}
#define WAIT_BAR(N) asm volatile("s_waitcnt vmcnt(" #N ") lgkmcnt(0)\n\ts_barrier":::"memory")

__device__ __forceinline__ void qkt(f32x16&p0,f32x16&p1,const char*Kslot,const bf16x8*qr,const f32x16&negm,int r32,int hi){
  const char*kb=Kslot+hi*1024+r32*16;
  #pragma unroll
  for(int d0=0;d0<4;++d0){
    const bf16x8 b0=*reinterpret_cast<const bf16x8*>(kb+d0*2048);
    const bf16x8 b1=*reinterpret_cast<const bf16x8*>(kb+d0*2048+512);
    if(d0==0){p0=__builtin_amdgcn_mfma_f32_32x32x16_bf16(b0,qr[0],negm,0,0,0);p1=__builtin_amdgcn_mfma_f32_32x32x16_bf16(b1,qr[0],negm,0,0,0);}
    else{p0=__builtin_amdgcn_mfma_f32_32x32x16_bf16(b0,qr[d0],p0,0,0,0);p1=__builtin_amdgcn_mfma_f32_32x32x16_bf16(b1,qr[d0],p1,0,0,0);}}
}
typedef __attribute__((address_space(3))) const char* lds_cptr;
typedef __attribute__((address_space(3))) const float* lds_fptr;
typedef short v4i16_t __attribute__((ext_vector_type(4)));
__device__ __forceinline__ void kload8(bf16x8*kf,lds_cptr kp){
  kf[0]=*(const __attribute__((address_space(3))) bf16x8*)(kp);      kf[1]=*(const __attribute__((address_space(3))) bf16x8*)(kp+512);
  kf[2]=*(const __attribute__((address_space(3))) bf16x8*)(kp+2048); kf[3]=*(const __attribute__((address_space(3))) bf16x8*)(kp+2560);
  kf[4]=*(const __attribute__((address_space(3))) bf16x8*)(kp+4096); kf[5]=*(const __attribute__((address_space(3))) bf16x8*)(kp+4608);
  kf[6]=*(const __attribute__((address_space(3))) bf16x8*)(kp+6144); kf[7]=*(const __attribute__((address_space(3))) bf16x8*)(kp+6656);
}
__device__ __forceinline__ void kload2(bf16x8*kf,lds_cptr kp,int j){ kf[2*j]=*(const __attribute__((address_space(3))) bf16x8*)(kp+j*2048); kf[2*j+1]=*(const __attribute__((address_space(3))) bf16x8*)(kp+j*2048+512); }
__device__ __forceinline__ s16x4 vtr(lds_cptr p){ return __builtin_bit_cast(s16x4,__builtin_amdgcn_ds_read_tr16_b64_v4i16((__attribute__((address_space(3))) v4i16_t*)p)); }
__device__ __forceinline__ float rowmax(const f32x16&p0,const f32x16&p1){
  float a=max3f(p0[0],p0[1],p1[0]),b=max3f(p0[2],p0[3],p1[1]);a=max3f(a,p1[2],p1[3]);
  #pragma unroll
  for(int r=4;r<16;r+=4){a=max3f(a,p0[r],p0[r+1]);b=max3f(b,p0[r+2],p0[r+3]);a=max3f(a,p1[r],p1[r+1]);b=max3f(b,p1[r+2],p1[r+3]);}
  const float m=max2f(a,b);
  auto rr=__builtin_amdgcn_permlane32_swap(__float_as_uint(m),__float_as_uint(m),false,false);
  return max2f(__uint_as_float(rr[0]),__uint_as_float(rr[1]));
}
__device__ __forceinline__ void pv(f32x16*o,int vb,bf16x8 pa0,bf16x8 pa1,bf16x8 pa2,bf16x8 pa3){
  #pragma unroll
  for(int d0=0;d0<2;++d0){s16x4 lo[4],hi[4];
    #pragma unroll
    for(int ks=0;ks<4;++ks){
      asm volatile("ds_read_b64_tr_b16 %0,%1 offset:%c2":"=&v"(lo[ks]):"v"(vb),"i"(d0*4096+ks*1024):"memory");
      asm volatile("ds_read_b64_tr_b16 %0,%1 offset:%c2":"=&v"(hi[ks]):"v"(vb),"i"(d0*4096+ks*1024+512):"memory");}
    asm volatile("s_waitcnt lgkmcnt(0)":::"memory");SBAR();
    #define PK(k) (bf16x8){lo[k][0],lo[k][1],lo[k][2],lo[k][3],hi[k][0],hi[k][1],hi[k][2],hi[k][3]}
    o[d0]=__builtin_amdgcn_mfma_f32_32x32x16_bf16(pa0,PK(0),o[d0],0,0,0);
    o[d0]=__builtin_amdgcn_mfma_f32_32x32x16_bf16(pa1,PK(1),o[d0],0,0,0);
    o[d0]=__builtin_amdgcn_mfma_f32_32x32x16_bf16(pa2,PK(2),o[d0],0,0,0);
    o[d0]=__builtin_amdgcn_mfma_f32_32x32x16_bf16(pa3,PK(3),o[d0],0,0,0);
    #undef PK
  }
}
__device__ __forceinline__ int t5_bucket(int d){
  if(d<16)return d;
  int b=16; b+=(d>=22); b+=(d>=30); b+=(d>=40); b+=(d>=54); b+=(d>=73); b+=(d>=99); b+=(d>=134); b+=(d>=182); b+=(d>=246); b+=(d>=332); b+=(d>=450); b+=(d>=609); b+=(d>=825); b+=(d>=1117); b+=(d>=1513);
  return b;
}
struct AttnJob {
  const bf16* Q; const bf16* K; const bf16* V; bf16* O; float* LSE;
  int q0, t0, NT;
  int W, PM;
  const float* biasg;
};
#ifndef ATTN_STORE16
#define ATTN_STORE16(p,v) (*(u32x4*)(p)=(v))
#endif
template<int THRL,bool WIN,int R> __device__ __forceinline__ void attn_unit(const AttnJob&J,char*shm){
  int tid_=threadIdx.x; asm volatile("":"+v"(tid_));
  const int tid=tid_,lane=tid&63,r32=lane&31,hi=lane>>5; const int wid=__builtin_amdgcn_readfirstlane(tid>>6);
  constexpr long pin=(long)R*9728; constexpr long pout=WIN?(long)R*512:1024; constexpr long plse=(long)R*8;
  const int q0=J.q0;
  const bf16*Qw=J.Q+(long)(q0+wid*QBLK)*pin;
  const bf16*Kh=J.K+(long)J.t0*KVBLK*pin,*Vh=J.V+(long)J.t0*KVBLK*pin;
  const unsigned lds0=(unsigned)(uintptr_t)shm;
  float*wsf=(float*)(shm+LDS_WS)+wid*64;
  const bf16*ksrc=Kh+(long)lane*pin+wid*8;
  const bf16*vsrc=Vh+(long)(16*(wid&3)+(lane>>2))*pin+(wid>>2)*32+(lane&3)*8;
  const unsigned kdst=lds0+LDS_K+wid*1024, vdst=lds0+LDS_V+wid*1024;
  #define DMA_K(t,slot) glds16(ksrc+(long)(t)*KVBLK*pin,(unsigned)__builtin_amdgcn_readfirstlane(kdst+(slot)))
  #define DMA_V(t,slot) glds16(vsrc+(long)(t)*KVBLK*pin,(unsigned)__builtin_amdgcn_readfirstlane(vdst+(slot)))
  const int vb0=(int)(lds0+LDS_V)+((lane>>4)&1)*32+(lane&3)*8+(4*hi+((lane&15)>>2))*64;
  const char*Kbase=shm+LDS_K; bf16x8 kf[8];
  const lds_cptr shm3=(lds_cptr)shm; const lds_cptr kp0=shm3+LDS_K+hi*1024+r32*16; const lds_cptr vp0=shm3+LDS_V+((lane>>4)&1)*32+(lane&3)*8+(4*hi+((lane&15)>>2))*64;
  const int NT=J.NT-J.t0;
  { const int npieces=(2*TPAD+q0-KVBLK*J.t0+255)>>8;
    for(int pc=wid;pc<npieces;pc+=NW) glds16((const char*)J.biasg+pc*1024+lane*16,(unsigned)__builtin_amdgcn_readfirstlane(lds0+LDS_BIAS+pc*1024)); }
  const lds_fptr Tb3=(lds_fptr)(shm3+LDS_BIAS);
  DMA_K(0,0);DMA_V(0,0);DMA_K(1,SLOTB);
  bf16x8 qr[4];
  #pragma unroll
  for(int d0=0;d0<4;++d0)qr[d0]=*reinterpret_cast<const bf16x8*>(&Qw[(long)r32*pin+d0*16+hi*8]);
  float mhat=0.f,l_reg=0.f;f32x16 o[2];o[0]=f32x16{};o[1]=f32x16{};f32x16 negm=f32x16{};asm volatile("":"+v"(negm));
  const int qrel=wid*QBLK+r32;
  const int tbase=TPAD+qrel-4*hi+64*(NT-4);
  #define BIAS(P0,P1,t) do{ const lds_fptr tp_=Tb3+(tbase-64*(t)); \
    _Pragma("unroll") for(int r=0;r<16;++r){ P0[r]+=tp_[-((r&3)+8*(r>>2))]; P1[r]+=tp_[-32-((r&3)+8*(r>>2))]; } }while(0)
  #define CMASK(P0,P1,t) do{ if(WIN){ wmask(P0,P1,64*((t)-(NT-4)),qrel,hi,J.W,J.PM); } else { int jb_=(t)-(NT-4); if(jb_>=0)cmask(P0,P1,jb_,qrel,hi); } }while(0)
  bool resc=false;
  #define START(P0,P1) do{ const float rm=rowmax(P0,P1); resc=false; \
    { const float dl=WIN?max2f(rm,-1000.f):rm; mhat=fadd_s(mhat,dl); \
      _Pragma("unroll") for(int r=0;r<16;++r){P0[r]=fsub_s(P0[r],dl);P1[r]=fsub_s(P1[r],dl);} \
      _Pragma("unroll") for(int r=0;r<16;++r)negm[r]=-mhat; asm volatile("":"+v"(negm)); } \
    _Pragma("unroll") for(int r=0;r<16;++r)P0[r]=__builtin_amdgcn_exp2f(P0[r]); }while(0)
  #define RESC() do{ if(resc){ asm volatile("s_waitcnt lgkmcnt(0)":::"memory"); \
      _Pragma("unroll") for(int d_=0;d_<2;++d_) _Pragma("unroll") for(int r=0;r<16;++r)o[d_][r]*=wsf[crow(r,hi)]; } }while(0)
  f32x16 pA0,pA1,pB0,pB1;
  int sl_prev=0,sl_cur=0,sl_next=SLOTB;
  #define ROT() do{sl_prev=sl_cur;sl_cur=sl_next;sl_next=(sl_next==(NSLOT-1)*SLOTB)?0:sl_next+SLOTB;}while(0)
  DMA_K(2,2*SLOTB);
  WAIT_BAR(3);
  qkt(pA0,pA1,Kbase,qr,negm,r32,hi);asm volatile("s_nop 15\n\ts_nop 7":"+v"(pA0),"+v"(pA1));BIAS(pA0,pA1,0);CMASK(pA0,pA1,0);
  START(pA0,pA1);
  _Pragma("unroll") for(int r=0;r<16;++r)pA1[r]=__builtin_amdgcn_exp2f(pA1[r]);
  WAIT_BAR(0);
  DMA_K(3,0);DMA_V(1,SLOTB);
  ROT();
  kload8(kf,kp0+sl_cur);
  WAIT_BAR(2);
  s16x4 vlo[8],vhi[8]; u32x4 pw0,pw1,pw2,pw3;
  #define PKW(P,B) cvtpk_s(P[B],P[B+1])
  #define PAF(k) __builtin_bit_cast(bf16x8,pw##k)
  #define VFR(i) (bf16x8){vlo[i][0],vlo[i][1],vlo[i][2],vlo[i][3],vhi[i][0],vhi[i][1],vhi[i][2],vhi[i][3]}
  #define PIN(x) asm volatile("":"+v"(x))
  #define MX3(a,b,c) __builtin_fmaxf(__builtin_fmaxf((a),(b)),(c))
  #define GAPA(MF,A0,A1,A2,A3,W0,W1,PW) do{ MF; sacc+=A0; sacc+=A1; sacc+=A2; sacc+=A3; PIN(sacc); W0; W1; PIN(PW); SBAR(); }while(0)
  #define EX(v) __builtin_amdgcn_exp2f(v)
  #define BLD(bb,OFF) do{ bb[0]=tq_[-(OFF)]; bb[1]=tq_[-(OFF)-1]; bb[2]=tq_[-(OFF)-2]; bb[3]=tq_[-(OFF)-3]; }while(0)
  #define GAPB(MF,X,B,bc,bn,NOFF) do{ if((NOFF)>=0){BLD(bn,NOFF);} MF; X[B]=EX(X[B]+bc[0]); X[B+1]=EX(X[B+1]+bc[1]); X[B+2]=EX(X[B+2]+bc[2]); X[B+3]=EX(X[B+3]+bc[3]); PIN(X); SBAR(); }while(0)
  #define VRD(i) do{ vlo[i]=vtr(vp_+(((i)>>2)*4096+((i)&3)*1024)); vhi[i]=vtr(vp_+(((i)>>2)*4096+((i)&3)*1024+512)); }while(0)
  #define KRD(G,j) do{ if(G){ kload2(kf,kp0+sl_next,j); SBAR(); } }while(0)
  #define STEP(C0,C1,P0,P1,t,GK,GV,GL,MSK) do{ SBAR(); \
    const lds_cptr vp_=vp0+sl_prev; \
    VRD(0); SBAR(); float sacc=(P0[0]+P0[1]); \
    GAPA(C0=__builtin_amdgcn_mfma_f32_32x32x16_bf16(kf[0],qr[0],negm,0,0,0), P0[2],P0[3],P0[4],P0[5],     pw0[0]=PKW(P0,0), pw0[1]=PKW(P0,2), pw0); \
    VRD(4); SBAR(); GAPA(C1=__builtin_amdgcn_mfma_f32_32x32x16_bf16(kf[1],qr[0],negm,0,0,0), P0[6],P0[7],P0[8],P0[9],     pw0[2]=PKW(P0,4), pw0[3]=PKW(P0,6), pw0); \
    VRD(1); SBAR(); GAPA(C0=__builtin_amdgcn_mfma_f32_32x32x16_bf16(kf[2],qr[1],C0,0,0,0),   P0[10],P0[11],P0[12],P0[13], pw1[0]=PKW(P0,8), pw1[1]=PKW(P0,10), pw1); \
    VRD(5); SBAR(); GAPA(C1=__builtin_amdgcn_mfma_f32_32x32x16_bf16(kf[3],qr[1],C1,0,0,0),   P0[14],P0[15],P1[0],P1[1],   pw1[2]=PKW(P0,12),pw1[3]=PKW(P0,14), pw1); \
    VRD(2); SBAR(); GAPA(C0=__builtin_amdgcn_mfma_f32_32x32x16_bf16(kf[4],qr[2],C0,0,0,0),   P1[2],P1[3],P1[4],P1[5],     pw2[0]=PKW(P1,0), pw2[1]=PKW(P1,2), pw2); \
    VRD(6); SBAR(); GAPA(C1=__builtin_amdgcn_mfma_f32_32x32x16_bf16(kf[5],qr[2],C1,0,0,0),   P1[6],P1[7],P1[8],P1[9],     pw2[2]=PKW(P1,4), pw2[3]=PKW(P1,6), pw2); \
    VRD(3); SBAR(); GAPA(C0=__builtin_amdgcn_mfma_f32_32x32x16_bf16(kf[6],qr[3],C0,0,0,0),   P1[10],P1[11],P1[12],P1[13], pw3[0]=PKW(P1,8), pw3[1]=PKW(P1,10), pw3); \
    VRD(7); SBAR(); GAPA(C1=__builtin_amdgcn_mfma_f32_32x32x16_bf16(kf[7],qr[3],C1,0,0,0),   P1[14],P1[15],0.f,0.f,       pw3[2]=PKW(P1,12),pw3[3]=PKW(P1,14), pw3); \
    l_reg+=sacc; \
    if(GK){DMA_K((t)+3,sl_cur);} if(GV){DMA_V((t)+1,sl_next);} \
    if(MSK){CMASK(C0,C1,t);} \
    const lds_fptr tq_=Tb3+(tbase-64*(t)); float bA_[4],bB_[4]; BLD(bA_,0); \
    { float a=MX3(C0[0],C0[1],C1[0]),b=MX3(C0[2],C0[3],C1[1]); a=MX3(a,C1[2],C1[3]); \
      _Pragma("unroll") for(int r=4;r<16;r+=4){a=MX3(a,C0[r],C0[r+1]);b=MX3(b,C0[r+2],C0[r+3]);a=MX3(a,C1[r],C1[r+1]);b=MX3(b,C1[r+2],C1[r+3]);} \
      float rm=__builtin_fmaxf(a,b); { auto rr=__builtin_amdgcn_permlane32_swap(__float_as_uint(rm),__float_as_uint(rm),false,false); rm=__builtin_fmaxf(__uint_as_float(rr[0]),__uint_as_float(rr[1])); } \
      resc=false; \
      if(__builtin_expect(__any(rm>(float)THRL),0)){ const float dl=__builtin_fmaxf(rm,0.f); mhat+=dl; \
        _Pragma("unroll") for(int r=0;r<16;++r){C0[r]-=dl;C1[r]-=dl;} \
        _Pragma("unroll") for(int r=0;r<16;++r)negm[r]=-mhat; asm volatile("":"+v"(negm)); \
        const float f=__builtin_amdgcn_exp2f(-dl); l_reg*=f; if(hi==0)wsf[r32]=f; resc=true; } } \
    SBAR(); \
    GAPB(o[0]=__builtin_amdgcn_mfma_f32_32x32x16_bf16(PAF(0),VFR(0),o[0],0,0,0), C0,0, bA_,bB_,8); \
    GAPB(o[1]=__builtin_amdgcn_mfma_f32_32x32x16_bf16(PAF(0),VFR(4),o[1],0,0,0), C0,4, bB_,bA_,16); \
    KRD(GL,0); GAPB(o[0]=__builtin_amdgcn_mfma_f32_32x32x16_bf16(PAF(1),VFR(1),o[0],0,0,0), C0,8, bA_,bB_,24); \
    KRD(GL,1); GAPB(o[1]=__builtin_amdgcn_mfma_f32_32x32x16_bf16(PAF(1),VFR(5),o[1],0,0,0), C0,12, bB_,bA_,32); \
    KRD(GL,2); GAPB(o[0]=__builtin_amdgcn_mfma_f32_32x32x16_bf16(PAF(2),VFR(2),o[0],0,0,0), C1,0, bA_,bB_,40); \
    KRD(GL,3); GAPB(o[1]=__builtin_amdgcn_mfma_f32_32x32x16_bf16(PAF(2),VFR(6),o[1],0,0,0), C1,4, bB_,bA_,48); \
    GAPB(o[0]=__builtin_amdgcn_mfma_f32_32x32x16_bf16(PAF(3),VFR(3),o[0],0,0,0), C1,8, bA_,bB_,56); \
    GAPB(o[1]=__builtin_amdgcn_mfma_f32_32x32x16_bf16(PAF(3),VFR(7),o[1],0,0,0), C1,12, bB_,bA_,-1); \
    }while(0)
  int t=1;
  if constexpr(!WIN){
  for(;t+5<NT;t+=2){
    STEP(pB0,pB1,pA0,pA1,t,true,true,true,false);     WAIT_BAR(2); RESC(); ROT();
    STEP(pA0,pA1,pB0,pB1,t+1,true,true,true,false);   WAIT_BAR(2); RESC(); ROT();
  }
  }
  #define ENDW(tt) do{ if((tt)+3<NT){WAIT_BAR(2);} else if((tt)+2<NT){WAIT_BAR(1);} else {WAIT_BAR(0);} }while(0)
  for(;t+1<NT;t+=2){
    STEP(pB0,pB1,pA0,pA1,t,(t+3<NT),(t+1<NT),(t+1<NT),true);       ENDW(t);   RESC(); ROT();
    STEP(pA0,pA1,pB0,pB1,t+1,(t+4<NT),(t+2<NT),(t+2<NT),true);     ENDW(t+1); RESC(); ROT();
  }
  STEP(pB0,pB1,pA0,pA1,NT-1,false,false,false,true); RESC();
  { float sacc=pB0[0]+pB0[1]; _Pragma("unroll") for(int r=2;r<16;++r)sacc+=pB0[r]; _Pragma("unroll") for(int r=0;r<16;++r)sacc+=pB1[r]; l_reg+=sacc;
    pw0=(u32x4){PKW(pB0,0),PKW(pB0,2),PKW(pB0,4),PKW(pB0,6)};pw1=(u32x4){PKW(pB0,8),PKW(pB0,10),PKW(pB0,12),PKW(pB0,14)};pw2=(u32x4){PKW(pB1,0),PKW(pB1,2),PKW(pB1,4),PKW(pB1,6)};pw3=(u32x4){PKW(pB1,8),PKW(pB1,10),PKW(pB1,12),PKW(pB1,14)};
    SBAR(); pv(o,vb0+sl_cur,PAF(0),PAF(1),PAF(2),PAF(3)); }
  #undef PKW
  #undef PAF
  #undef VFR
  #undef PIN
  #undef MX3
  #undef GAPA
  #undef GAPB
  #undef BLD
  #undef EX
  #undef VRD
  #undef KRD
  #undef STEP
  #undef ENDW
  {auto rr=__builtin_amdgcn_permlane32_swap(__float_as_uint(l_reg),__float_as_uint(l_reg),false,false);l_reg=__uint_as_float(rr[0])+__uint_as_float(rr[1]);}
  if(J.LSE!=nullptr && hi==0) J.LSE[(long)(q0+qrel)*plse]=(mhat+__builtin_amdgcn_logf(l_reg))*0.6931471805599453f;
  if(hi==0)wsf[32+r32]=l_reg;asm volatile("s_waitcnt lgkmcnt(0)":::"memory");
  float rli[16];
  #pragma unroll
  for(int r=0;r<16;++r)rli[r]=__builtin_amdgcn_rcpf(wsf[32+crow(r,hi)]);
  bf16*Ow=J.O+(long)(q0+wid*QBLK)*pout;
  { bf16*stg=(bf16*)(shm+LDS_OST)+wid*2048;
    #pragma unroll
    for(int r=0;r<16;++r){const int orow=crow(r,hi);
      #pragma unroll
      for(int d0=0;d0<2;++d0)stg[orow*64+d0*32+r32]=__float2bfloat16(o[d0][r]*rli[r]);}
    asm volatile("s_waitcnt lgkmcnt(0)":::"memory");
    #pragma unroll
    for(int i=0;i<4;++i){const int row=i*8+(lane>>3),ch=lane&7; const u32x4 v=*(const u32x4*)(stg+row*64+ch*8); ATTN_STORE16(Ow+(long)row*pout+ch*8,v);} }
  asm volatile("s_waitcnt lgkmcnt(0)\n\ts_barrier":::"memory");
  #undef DMA_K
  #undef DMA_V
  #undef CMASK
  #undef BIAS
  #undef START
  #undef RESC
  #undef ROT
}
constexpr int ATTN_LDS_BYTES=LDS_BYTES;
#undef SBAR
#undef WAIT_BAR
}
constexpr int NWAVES = 8;
constexpr int NB = 8, SEQ = 2048, DM = 1024, DEPTH = 4, M = NB * SEQ;
constexpr int INW = 9728;
constexpr int COL_QA = 0, COL_KA = 1536, COL_VA = 3072, COL_QB = 4608, COL_KB = 5632, COL_VB = 6656, COL_GA = 7680, COL_GB = 8704;
constexpr int NEXP = 16384, PHEADS = 8, TOPK = 16, PQW = 2048;
constexpr float NORM_EPS = 1e-6f, SUBLN_EPS = 1e-5f;
constexpr size_t MiB = 1u << 20;
constexpr size_t WS_CTL = 0, CTL_ZERO_BYTES = 1 * MiB;
constexpr size_t WS_MOD = 1 * MiB;
constexpr size_t WS_SUBK = 2 * MiB;
constexpr size_t WS_BIAS = 3 * MiB;
constexpr size_t WS_SU = 3 * MiB + 512 * 1024, WS_SV = 3 * MiB + 768 * 1024;
constexpr size_t WS_WPA = 4 * MiB;
constexpr size_t WS_WPB = 8 * MiB;
constexpr size_t WS_WO = 16 * MiB;
constexpr size_t WS_WQ = 24 * MiB;
constexpr size_t WS_WIN = 40 * MiB;
constexpr size_t WS_U = 116 * MiB;
constexpr size_t WS_V = 244 * MiB;
constexpr size_t WS_H = 372 * MiB;
constexpr size_t WS_PROJ = 404 * MiB;
constexpr size_t WS_PQ = WS_PROJ;
constexpr size_t WS_IDS = WS_PROJ + 64 * MiB;
constexpr size_t WS_GATES = WS_PROJ + 72 * MiB;
constexpr size_t WS_ODIFF = 708 * MiB;
constexpr size_t WS_TMP = WS_ODIFF;
constexpr size_t WS_ODIL = 772 * MiB;
constexpr size_t WS_MERGED = WS_ODIL;
constexpr size_t WS_LSE = 820 * MiB;
constexpr size_t WS_OA = 822 * MiB;
constexpr size_t WS_OB = 838 * MiB;
constexpr size_t WS_END = 870 * MiB;
constexpr size_t WS_DBG = 880 * MiB;
constexpr int CW_BAR = 4096;
constexpr int RING_BYTES = 131072;
constexpr int LDSCTL_OFF = RING_BYTES, MISC_OFF = LDSCTL_OFF + 320;
constexpr int LDS_BYTES = 147456;
constexpr int PH_PRO_A = 0, PH_PRO_B = 1, PH_LAYER0 = 2, PH_PER_LAYER = 9, NPHASE = PH_LAYER0 + DEPTH * PH_PER_LAYER;

#define GAS __attribute__((address_space(1)))
#define LAS __attribute__((address_space(3)))
typedef unsigned short bf16;
typedef unsigned v4u __attribute__((ext_vector_type(4)));
typedef unsigned v2u __attribute__((ext_vector_type(2)));
typedef float f32x4 __attribute__((ext_vector_type(4)));
typedef float f32x16 __attribute__((ext_vector_type(16)));
typedef short bf16x8 __attribute__((ext_vector_type(8)));
typedef __bf16 bf16x2_t __attribute__((ext_vector_type(2)));
typedef GAS unsigned gu32;
#define RLX_AGENT __ATOMIC_RELAXED, __HIP_MEMORY_SCOPE_AGENT
#define LDS_WAIT() asm volatile("s_waitcnt lgkmcnt(0)" ::: "memory")
#define VM_WAIT() asm volatile("s_waitcnt vmcnt(0)" ::: "memory")
__device__ __forceinline__ unsigned f2bf(float f) { unsigned u = __builtin_bit_cast(unsigned, f); return (u + 0x7fffu + ((u >> 16) & 1u)) >> 16; }
__device__ __forceinline__ unsigned pk2(float lo, float hi) { return f2bf(lo) | (f2bf(hi) << 16); }
__device__ __forceinline__ float bflo(unsigned w) { return __uint_as_float(w << 16); }
__device__ __forceinline__ float bfhi(unsigned w) { return __uint_as_float(w & 0xffff0000u); }
#define XB_TMO      128
#define XB_XCNT(j)  (256  + 64 * (j))
#define XB_XSUB(j)  (1280 + 64 * (j))
#define XB_XGEN(j)  (2304 + 64 * (j))
#define XB_TOP      3328
#define XB_TOPGEN   3392
#define XCD_BAR_WORDS 3456
#define XB_SPIN_CAP (1u << 18)

__device__ __forceinline__ unsigned xb_ld(unsigned* p)              { return __hip_atomic_load(p, __ATOMIC_RELAXED, __HIP_MEMORY_SCOPE_AGENT); }
__device__ __forceinline__ unsigned xb_add(unsigned* p, unsigned v) { return __hip_atomic_fetch_add(p, v, __ATOMIC_RELAXED, __HIP_MEMORY_SCOPE_AGENT); }
__device__ __forceinline__ unsigned xb_xcc_id() { return (unsigned)__builtin_amdgcn_s_getreg((3 << 11) | 20) & 0xFu; }
#define XB_SPIN(cond, bar) do { unsigned _sp = 0; while (cond) { __builtin_amdgcn_s_sleep(1); \
    if ((++_sp & 255u) == 0u) { if (xb_ld(&(bar)[XB_TMO])) break; if (_sp > XB_SPIN_CAP) { atomicAdd(&(bar)[XB_TMO], 1u); break; } } } } while (0)

struct XcdBarrier {
    unsigned* bar; unsigned x;
    volatile LAS unsigned* st;
};

__device__ __forceinline__ XcdBarrier xcd_barrier_post(unsigned* bar, volatile LAS unsigned* st) {
    XcdBarrier b; b.bar = bar; b.x = xb_xcc_id(); b.st = st;
    if (threadIdx.x == 0) (void)xb_add(&bar[XB_XCNT(b.x)], 1u);
    return b;
}
__device__ __forceinline__ void xcd_barrier_complete(unsigned* bar, unsigned x, unsigned& nloc, unsigned& nx) {
    const unsigned G = gridDim.x * gridDim.y * gridDim.z;
    unsigned sum, cnt, mine, sp = 0u;
    for (;;) {
        sum = 0u; cnt = 0u; mine = 0u;
#pragma unroll
        for (unsigned j = 0; j < 16; ++j) { const unsigned c = xb_ld(&bar[XB_XCNT(j)]); sum += c; cnt += (c > 0u) ? 1u : 0u; mine = (j == x) ? c : mine; }
        if (sum == G) break;
        __builtin_amdgcn_s_sleep(1);
        if ((++sp & 255u) == 0u) { if (xb_ld(&bar[XB_TMO])) break; if (sp > XB_SPIN_CAP) { atomicAdd(&bar[XB_TMO], 1u); break; } }
    }
    nloc = mine > 0u ? mine : 1u; nx = cnt > 0u ? cnt : 1u;
}

__device__ __forceinline__ void xcd_barrier(const XcdBarrier& b) {
    asm volatile("s_waitcnt vmcnt(0)" ::: "memory");
    __syncthreads();
    if (threadIdx.x == 0) {
        unsigned* bar = b.bar;
        __builtin_amdgcn_s_waitcnt(0);
        unsigned nloc = b.st[0], nx = b.st[1];
        if (nloc == 0u) { xcd_barrier_complete(bar, b.x, nloc, nx); b.st[0] = nloc; b.st[1] = nx; }
        const unsigned old = xb_add(&bar[XB_XSUB(b.x)], 1u);
        const unsigned gen = old / nloc;
        if (old + 1u == (gen + 1u) * nloc) {
            __builtin_amdgcn_fence(__ATOMIC_RELEASE, "agent");
            asm volatile("s_waitcnt vmcnt(0)" ::: "memory");
            const unsigned og = xb_add(&bar[XB_TOP], 1u);
            const unsigned tg = og / nx;
            if (og + 1u == (tg + 1u) * nx) xb_add(&bar[XB_TOPGEN], 1u);
            else XB_SPIN(xb_ld(&bar[XB_TOPGEN]) == tg, bar);
            __builtin_amdgcn_fence(__ATOMIC_ACQUIRE, "agent");
            xb_add(&bar[XB_XGEN(b.x)], 1u);
            asm volatile("s_waitcnt vmcnt(0)" ::: "memory");
        } else {
            XB_SPIN(xb_ld(&bar[XB_XGEN(b.x)]) == gen, bar);
            __builtin_amdgcn_fence(__ATOMIC_ACQUIRE, "agent");
            asm volatile("s_waitcnt vmcnt(0)" ::: "memory");
        }
    }
    __syncthreads();
}
struct Args { const float* in[21]; float* out; unsigned char* ws; int ph_lo, ph_hi; };
struct Frame {
    LAS unsigned char* lds; unsigned char* ldsg;
    int tid, lane, wave, vcu, G;
};
__device__ __forceinline__ float wave_sum(float v) {
#pragma unroll
    for (int o = 1; o < 64; o <<= 1) v += __shfl_xor(v, o);
    return v;
}
__device__ __forceinline__ void p0_transpose_item(const float* W, int K, int N, bf16* WT, LAS float* scr, int item, int lane) {
    const int nblk = N / 32, kb = item / nblk, nb = item % nblk, k0 = 64 * kb, n0 = 32 * nb;
#pragma unroll 8
    for (int i = 0; i < 32; ++i) { const int kk = 2 * i + (lane >> 5); scr[kk * 33 + (lane & 31)] = W[(size_t)(k0 + kk) * N + n0 + (lane & 31)]; }
    LDS_WAIT(); asm volatile("" ::: "memory");
    const int c = lane & 7;
#pragma unroll
    for (int j = 0; j < 4; ++j) { const int n = (lane >> 3) + 8 * j; const LAS float* s = scr + (8 * c) * 33 + n;
        v4u o; o.x = pk2(s[0 * 33], s[1 * 33]); o.y = pk2(s[2 * 33], s[3 * 33]); o.z = pk2(s[4 * 33], s[5 * 33]); o.w = pk2(s[6 * 33], s[7 * 33]);
        *(GAS v4u*)(WT + (size_t)(n0 + n) * K + k0 + 8 * c) = o; }
    LDS_WAIT(); asm volatile("" ::: "memory");
}
__device__ __forceinline__ void cvt_stream(const float* src, bf16* dst, size_t nchunks, size_t gtid, size_t nthreads) {
    for (size_t c = gtid; c < nchunks; c += nthreads) { const f32x4 a = *(const GAS f32x4*)(src + c * 8), b = *(const GAS f32x4*)(src + c * 8 + 4);
        v4u o; o.x = pk2(a.x, a.y); o.y = pk2(a.z, a.w); o.z = pk2(b.x, b.y); o.w = pk2(b.z, b.w); *(GAS v4u*)(dst + c * 8) = o; }
}
__device__ __forceinline__ void prologue_a(Frame& F, const Args& A) {
    const int gw = F.vcu * NWAVES + F.wave, NGW = F.G * NWAVES;
    { LAS float* scr = (LAS float*)(F.lds + F.wave * 16384);
      constexpr int I_IN = (DM / 64) * (INW / 32), I_PA = (512 / 64) * (DM / 32), I_PB = (DM / 64) * (DM / 32), I_O = I_PB, I_Q = (DM / 64) * (PQW / 32);
      constexpr int PER_L = I_IN + I_PA + I_PB + I_O + I_Q, NITEMS = DEPTH * PER_L;
      for (int it = gw; it < NITEMS; it += NGW) {
          const int l = it / PER_L; int r = it % PER_L;
          if (r < I_IN) { p0_transpose_item(A.in[6] + (size_t)l * DM * INW, DM, INW, (bf16*)(A.ws + WS_WIN) + (size_t)l * INW * DM, scr, r, F.lane); continue; } r -= I_IN;
          if (r < I_PA) { p0_transpose_item(A.in[7] + (size_t)l * 512 * DM, 512, DM, (bf16*)(A.ws + WS_WPA) + (size_t)l * DM * 512, scr, r, F.lane); continue; } r -= I_PA;
          if (r < I_PB) { p0_transpose_item(A.in[8] + (size_t)l * DM * DM, DM, DM, (bf16*)(A.ws + WS_WPB) + (size_t)l * DM * DM, scr, r, F.lane); continue; } r -= I_PB;
          if (r < I_O) { p0_transpose_item(A.in[9] + (size_t)l * DM * DM, DM, DM, (bf16*)(A.ws + WS_WO) + (size_t)l * DM * DM, scr, r, F.lane); continue; } r -= I_O;
          p0_transpose_item(A.in[16] + (size_t)l * DM * PQW, DM, PQW, (bf16*)(A.ws + WS_WQ) + (size_t)l * PQW * DM, scr, r, F.lane);
      } }
    { const size_t gtid = (size_t)gw * 64 + F.lane, nthr = (size_t)NGW * 64;
      for (int rr = gw; rr < 2 * DEPTH * NEXP; rr += NGW) { const int tb = rr >= DEPTH * NEXP, row = tb ? rr - DEPTH * NEXP : rr;
          const float* src = (tb ? A.in[19] : A.in[18]) + (size_t)row * DM + 16 * F.lane;
          const f32x4 a0 = *(const GAS f32x4*)src, a1 = *(const GAS f32x4*)(src + 4), a2 = *(const GAS f32x4*)(src + 8), a3 = *(const GAS f32x4*)(src + 12);
          float am = fmaxf(fmaxf(fmaxf(fabsf(a0.x), fabsf(a0.y)), fmaxf(fabsf(a0.z), fabsf(a0.w))), fmaxf(fmaxf(fabsf(a1.x), fabsf(a1.y)), fmaxf(fabsf(a1.z), fabsf(a1.w))));
          am = fmaxf(am, fmaxf(fmaxf(fmaxf(fabsf(a2.x), fabsf(a2.y)), fmaxf(fabsf(a2.z), fabsf(a2.w))), fmaxf(fmaxf(fabsf(a3.x), fabsf(a3.y)), fmaxf(fabsf(a3.z), fabsf(a3.w)))));
#pragma unroll
          for (int o = 1; o < 64; o <<= 1) am = fmaxf(am, __shfl_xor(am, o));
          const float sc = am > 0.f ? 256.0f / am : 1.0f;
          int w0 = 0, w1 = 0, w2 = 0, w3 = 0;
          w0 = __builtin_amdgcn_cvt_pk_fp8_f32(a0.x * sc, a0.y * sc, w0, false); w0 = __builtin_amdgcn_cvt_pk_fp8_f32(a0.z * sc, a0.w * sc, w0, true);
          w1 = __builtin_amdgcn_cvt_pk_fp8_f32(a1.x * sc, a1.y * sc, w1, false); w1 = __builtin_amdgcn_cvt_pk_fp8_f32(a1.z * sc, a1.w * sc, w1, true);
          w2 = __builtin_amdgcn_cvt_pk_fp8_f32(a2.x * sc, a2.y * sc, w2, false); w2 = __builtin_amdgcn_cvt_pk_fp8_f32(a2.z * sc, a2.w * sc, w2, true);
          w3 = __builtin_amdgcn_cvt_pk_fp8_f32(a3.x * sc, a3.y * sc, w3, false); w3 = __builtin_amdgcn_cvt_pk_fp8_f32(a3.z * sc, a3.w * sc, w3, true);
          *(GAS v4u*)((unsigned char*)(A.ws + (tb ? WS_V : WS_U)) + (size_t)row * DM + 16 * F.lane) = (v4u){(unsigned)w0, (unsigned)w1, (unsigned)w2, (unsigned)w3};
          if (F.lane == 0) ((float*)(A.ws + (tb ? WS_SV : WS_SU)))[row] = am > 0.f ? am * (1.0f / 256.0f) : 1.0f; }
      cvt_stream(A.in[17], (bf16*)(A.ws + WS_SUBK), (size_t)DEPTH * 2 * 128 * 128 / 8, gtid, nthr);
      float* BT = (float*)(A.ws + WS_BIAS);
      for (size_t i = gtid; i < (size_t)32 * attn_body::TBLN; i += nthr) { const int hd = (int)(i / attn_body::TBLN), d = (int)(i % attn_body::TBLN) - attn_body::TPAD;
          const int st = (hd < 8 || hd >= 24) ? 1 : (hd < 16 ? 4 : 8); float v = 0.f;
          if (d >= 0) { int dist = d * st; dist = dist > 2047 ? 2047 : dist; v = A.in[15][attn_body::t5_bucket(dist) * 32 + hd] * 1.4426950408889634f; }
          BT[i] = v; } }
    __syncthreads();
    { LAS float* sil = (LAS float*)F.lds;
      LAS float* red = (LAS float*)(F.lds + 32768);
      for (int i = F.tid; i < NB * DM; i += NWAVES * 64) { const float v = A.in[1][i]; sil[i] = v / (1.0f + __expf(-v)); }
      __syncthreads();
      constexpr int NJB = 6 * DM / 64;
      for (int u = F.vcu; u < DEPTH * NJB; u += F.G) {
          const int l = u / NJB, jb = u % NJB, j = jb * 64 + F.lane;
          const float* Wp = A.in[2] + (size_t)l * DM * 6 * DM + (size_t)(F.wave * 128) * 6 * DM + j;
          float acc[8];
#pragma unroll
          for (int b = 0; b < 8; ++b) acc[b] = 0.f;
#pragma unroll 8
          for (int k = 0; k < 128; ++k) { const float w = Wp[(size_t)k * 6 * DM];
#pragma unroll
              for (int b = 0; b < 8; ++b) acc[b] += sil[b * DM + F.wave * 128 + k] * w; }
#pragma unroll
          for (int b = 0; b < 8; ++b) red[(F.wave * 8 + b) * 64 + F.lane] = acc[b];
          __syncthreads();
          { const int b = F.tid >> 6, ln = F.tid & 63; float s = 0.f;
#pragma unroll
            for (int w = 0; w < 8; ++w) s += red[(w * 8 + b) * 64 + ln];
            ((float*)(A.ws + WS_MOD))[((size_t)l * NB + b) * 6 * DM + jb * 64 + ln] = s + A.in[3][(size_t)l * 6 * DM + jb * 64 + ln]; }
          __syncthreads();
      } }
}
__device__ __forceinline__ void norm_row_store(const f32x4 (&v)[4], const float* g, const float* sc, const float* sh, bf16* orow, int lane) {
    float s = 0.f;
#pragma unroll
    for (int j = 0; j < 4; ++j) s += (v[j].x * v[j].x + v[j].y * v[j].y) + (v[j].z * v[j].z + v[j].w * v[j].w);
    const float r = 1.0f / sqrtf(wave_sum(s) * (1.0f / DM) + NORM_EPS);
    GAS v2u* o8 = (GAS v2u*)orow + lane;
#pragma unroll
    for (int j = 0; j < 4; ++j) { const int c = 4 * lane + 256 * j; const f32x4 gg = *(const f32x4*)(g + c), cc = *(const f32x4*)(sc + c), hh = *(const f32x4*)(sh + c);
        const f32x4 y = v[j] * r * gg * (cc + 1.0f) + hh; v2u w; w.x = pk2(y.x, y.y); w.y = pk2(y.z, y.w); o8[64 * j] = w; }
}
__device__ __forceinline__ void prologue_b(Frame& F, const Args& A) {
    const int gw = F.vcu * NWAVES + F.wave, NGW = F.G * NWAVES;
    const float* mod = (const float*)(A.ws + WS_MOD);
    for (int m = gw; m < M; m += NGW) { const int b = m / SEQ;
        const GAS f32x4* xr = (const GAS f32x4*)(A.in[0] + (size_t)m * DM) + F.lane; GAS f32x4* xo = (GAS f32x4*)(A.out + (size_t)m * DM) + F.lane;
        f32x4 v[4];
#pragma unroll
        for (int j = 0; j < 4; ++j) { v[j] = xr[64 * j]; xo[64 * j] = v[j]; }
        norm_row_store(v, A.in[4], mod + (size_t)b * 6 * DM + 1 * DM, mod + (size_t)b * 6 * DM + 0 * DM, (bf16*)(A.ws + WS_H) + (size_t)m * DM, F.lane); }
}
__device__ __forceinline__ void norm2_phase(Frame& F, const Args& A, int l) {
    const int gw = F.vcu * NWAVES + F.wave, NGW = F.G * NWAVES;
    const float* mod = (const float*)(A.ws + WS_MOD) + (size_t)l * NB * 6 * DM;
    for (int m = gw; m < M; m += NGW) { const int b = m / SEQ;
        const GAS f32x4* xr = (const GAS f32x4*)(A.out + (size_t)m * DM) + F.lane;
        f32x4 v[4];
#pragma unroll
        for (int j = 0; j < 4; ++j) v[j] = xr[64 * j];
        norm_row_store(v, A.in[5] + (size_t)l * DM, mod + (size_t)b * 6 * DM + 4 * DM, mod + (size_t)b * 6 * DM + 3 * DM, (bf16*)(A.ws + WS_H) + (size_t)m * DM, F.lane); }
}
__device__ __forceinline__ void attn_phase_all(Frame& F, const Args& A) {
    using namespace attn_body;
    const __hip_bfloat16* P = (const __hip_bfloat16*)(A.ws + WS_PROJ);
    __hip_bfloat16* OD = (__hip_bfloat16*)(A.ws + WS_ODIFF); __hip_bfloat16* OG = (__hip_bfloat16*)(A.ws + WS_ODIL); float* LS = (float*)(A.ws + WS_LSE);
    const float* BT = (const float*)(A.ws + WS_BIAS);
    constexpr int NUNITS = 14 * 256;
    for (int L = F.vcu; L < NUNITS; L += F.G) {
        const int round = L >> 8, c = L & 255;
        AttnJob J;
        if (round < 8) {
            const int b = c >> 5, h = (c >> 2) & 7, sub = (c >> 1) & 1, vh = c & 1; const int qb = (round & 1) ? (round >> 1) : 7 - (round >> 1);
            const size_t rb = (size_t)b * SEQ;
            J.Q = P + rb * INW + COL_QB + h * 128 + sub * 64; J.K = P + rb * INW + COL_KB + h * 128 + sub * 64; J.V = P + rb * INW + COL_VB + h * 128 + vh * 64;
            J.O = OD + (size_t)sub * M * DM + rb * DM + h * 128 + vh * 64; J.LSE = nullptr;
            J.q0 = 256 * qb; J.t0 = 0; J.NT = 4 * qb + 4; J.W = 0; J.PM = 0; J.biasg = BT + (size_t)(24 + h) * attn_body::TBLN;
            attn_unit<8, false, 1>(J, (char*)F.ldsg);
        } else {
            int g, b, h, m, qb, r, W, PM;
            const int u = 2 * c + (round & 1);
            if (round < 10) { g = 0; b = u >> 6; h = (u >> 3) & 7; m = 0; qb = u & 7; r = 1; W = 128; PM = 0; }
            else if (round < 12) { g = 1; b = u >> 6; h = (u >> 3) & 7; m = (u >> 1) & 3; qb = u & 1; r = 4; W = 128; PM = 0; }
            else { g = 2; b = u >> 6; h = (u >> 3) & 7; m = u & 7; qb = 0; r = 8; W = 256; PM = 1; }
            const size_t rb = (size_t)b * SEQ + m;
            J.Q = P + rb * INW + COL_QA + g * 512 + h * 64; J.K = P + rb * INW + COL_KA + g * 512 + h * 64; J.V = P + rb * INW + COL_VA + g * 512 + h * 64;
            J.O = OG + (size_t)g * M * 512 + rb * 512 + h * 64; J.LSE = LS + (size_t)g * M * 8 + rb * 8 + h;
            J.q0 = 256 * qb; J.t0 = (qb > 0) ? 4 * qb - 2 : 0; J.NT = 4 * qb + 4; J.W = W; J.PM = PM; J.biasg = BT + (size_t)(8 * g + h) * attn_body::TBLN;
            if (g == 0) attn_unit<8, true, 1>(J, (char*)F.ldsg); else if (g == 1) attn_unit<8, true, 4>(J, (char*)F.ldsg); else attn_unit<8, true, 8>(J, (char*)F.ldsg);
        }
    }
}
__device__ __forceinline__ void combine_phase(Frame& F, const Args& A, int l) {
    const int gw = F.vcu * NWAVES + F.wave, NGW = F.G * NWAVES, lane = F.lane;
    const float lam_init = 0.8f - 0.6f * expf(-0.3f * (float)l);
    const float d1 = wave_sum(A.in[10][l * 64 + lane] * A.in[11][l * 64 + lane]), d2 = wave_sum(A.in[12][l * 64 + lane] * A.in[13][l * 64 + lane]);
    const float lam = expf(d1) - expf(d2) + lam_init;
    const bf16* OG = (const bf16*)(A.ws + WS_ODIL); const float* LS = (const float*)(A.ws + WS_LSE); const bf16* OD = (const bf16*)(A.ws + WS_ODIFF);
    bf16* OA = (bf16*)(A.ws + WS_OA); bf16* OB = (bf16*)(A.ws + WS_OB);
    const int hd = lane >> 3, c8 = (lane & 7) * 8, c16 = (lane & 7) * 16;
    float sg[16];
#pragma unroll
    for (int i = 0; i < 16; ++i) sg[i] = A.in[14][l * 128 + c16 + i] * (1.0f - lam_init);
    for (int t = gw; t < M; t += NGW) {
        { const float l0 = LS[(size_t)t * 8 + hd], l1 = LS[(size_t)M * 8 + (size_t)t * 8 + hd], l2 = LS[(size_t)2 * M * 8 + (size_t)t * 8 + hd];
          const float mx = fmaxf(l0, fmaxf(l1, l2)); float w0 = __expf(l0 - mx), w1 = __expf(l1 - mx), w2 = __expf(l2 - mx); const float inv = 1.0f / (w0 + w1 + w2); w0 *= inv; w1 *= inv; w2 *= inv;
          const v4u a = *(const GAS v4u*)(OG + (size_t)t * 512 + hd * 64 + c8), b = *(const GAS v4u*)(OG + (size_t)M * 512 + (size_t)t * 512 + hd * 64 + c8), c = *(const GAS v4u*)(OG + (size_t)2 * M * 512 + (size_t)t * 512 + hd * 64 + c8);
          v4u o;
          o.x = pk2(w0 * bflo(a.x) + w1 * bflo(b.x) + w2 * bflo(c.x), w0 * bfhi(a.x) + w1 * bfhi(b.x) + w2 * bfhi(c.x));
          o.y = pk2(w0 * bflo(a.y) + w1 * bflo(b.y) + w2 * bflo(c.y), w0 * bfhi(a.y) + w1 * bfhi(b.y) + w2 * bfhi(c.y));
          o.z = pk2(w0 * bflo(a.z) + w1 * bflo(b.z) + w2 * bflo(c.z), w0 * bfhi(a.z) + w1 * bfhi(b.z) + w2 * bfhi(c.z));
          o.w = pk2(w0 * bflo(a.w) + w1 * bflo(b.w) + w2 * bflo(c.w), w0 * bfhi(a.w) + w1 * bfhi(b.w) + w2 * bfhi(c.w));
          *(GAS v4u*)(OA + (size_t)t * 512 + hd * 64 + c8) = o; }
        { const bf16* p0 = OD + (size_t)t * DM + hd * 128 + c16; const bf16* p1 = OD + (size_t)M * DM + (size_t)t * DM + hd * 128 + c16;
          const v4u a0 = *(const GAS v4u*)p0, a1 = *(const GAS v4u*)(p0 + 8), b0 = *(const GAS v4u*)p1, b1 = *(const GAS v4u*)(p1 + 8);
          float o[16];
          o[0] = bflo(a0.x) - lam * bflo(b0.x); o[1] = bfhi(a0.x) - lam * bfhi(b0.x); o[2] = bflo(a0.y) - lam * bflo(b0.y); o[3] = bfhi(a0.y) - lam * bfhi(b0.y);
          o[4] = bflo(a0.z) - lam * bflo(b0.z); o[5] = bfhi(a0.z) - lam * bfhi(b0.z); o[6] = bflo(a0.w) - lam * bflo(b0.w); o[7] = bfhi(a0.w) - lam * bfhi(b0.w);
          o[8] = bflo(a1.x) - lam * bflo(b1.x); o[9] = bfhi(a1.x) - lam * bfhi(b1.x); o[10] = bflo(a1.y) - lam * bflo(b1.y); o[11] = bfhi(a1.y) - lam * bfhi(b1.y);
          o[12] = bflo(a1.z) - lam * bflo(b1.z); o[13] = bfhi(a1.z) - lam * bfhi(b1.z); o[14] = bflo(a1.w) - lam * bflo(b1.w); o[15] = bfhi(a1.w) - lam * bfhi(b1.w);
          float ss = 0.f;
#pragma unroll
          for (int i = 0; i < 16; ++i) ss += o[i] * o[i];
          ss += __shfl_xor(ss, 1); ss += __shfl_xor(ss, 2); ss += __shfl_xor(ss, 4);
          const float r = 1.0f / sqrtf(ss * (1.0f / 128.0f) + SUBLN_EPS);
          v4u w0, w1;
          w0.x = pk2(o[0] * r * sg[0], o[1] * r * sg[1]); w0.y = pk2(o[2] * r * sg[2], o[3] * r * sg[3]); w0.z = pk2(o[4] * r * sg[4], o[5] * r * sg[5]); w0.w = pk2(o[6] * r * sg[6], o[7] * r * sg[7]);
          w1.x = pk2(o[8] * r * sg[8], o[9] * r * sg[9]); w1.y = pk2(o[10] * r * sg[10], o[11] * r * sg[11]); w1.z = pk2(o[12] * r * sg[12], o[13] * r * sg[13]); w1.w = pk2(o[14] * r * sg[14], o[15] * r * sg[15]);
          bf16* q = OB + (size_t)t * DM + hd * 128 + c16; *(GAS v4u*)q = w0; *(GAS v4u*)(q + 8) = w1; }
    }
}
#define CE_DESC(a, b) do { const float _hi = fmaxf(a, b), _lo = fminf(a, b); a = _hi; b = _lo; } while (0)
__device__ __forceinline__ void sort16_desc(float (&v)[16]) {
#pragma unroll
    for (int k = 2; k <= 16; k <<= 1)
#pragma unroll
        for (int j = k >> 1; j > 0; j >>= 1)
#pragma unroll
            for (int i = 0; i < 16; ++i) { const int p = i ^ j; if (p > i) { if ((i & k) == 0) { CE_DESC(v[i], v[p]); } else { CE_DESC(v[p], v[i]); } } }
}
__device__ __forceinline__ void merge16_desc(float (&a)[16], const float (&b)[16]) {
#pragma unroll
    for (int i = 0; i < 16; ++i) a[i] = fmaxf(a[i], b[15 - i]);
#pragma unroll
    for (int j = 8; j > 0; j >>= 1)
#pragma unroll
        for (int i = 0; i < 16; ++i) { const int p = i ^ j; if (p > i) CE_DESC(a[i], a[p]); }
}
__device__ __forceinline__ float pack_idx(float v, unsigned idx, unsigned mask) { return __uint_as_float((__float_as_uint(v) & ~mask) | idx); }
__device__ __forceinline__ void topk_phase(Frame& F, const Args& A, int l) {
    const int gw = F.vcu * NWAVES + F.wave, NGW = F.G * NWAVES, lane = F.lane, r32 = lane & 31, hi = lane >> 5;
    { const bf16* SK = (const bf16*)(A.ws + WS_SUBK) + (size_t)l * 2 * 128 * 128;
      for (int c = F.tid; c < 256 * 16; c += NWAVES * 64) { const int row = c >> 4, ch = c & 15; const v4u v = *(const GAS v4u*)(SK + row * 128 + ch * 8); *(LAS v4u*)(F.lds + row * 272 + ch * 16) = v; }
      __syncthreads(); }
    LAS unsigned char* sk = F.lds;
    LAS unsigned char* ibuf = F.lds + 69632 + F.wave * 2048 + lane * 32;
    const bf16* PQ = (const bf16*)(A.ws + WS_PQ);
    int* IDS = (int*)(A.ws + WS_IDS); float* GT = (float*)(A.ws + WS_GATES);
    for (int unit = gw; unit < (M / 32) * PHEADS; unit += NGW) {
        const int tile = unit >> 3, h = unit & 7, tok = tile * 32 + r32;
        const bf16* qrow = PQ + (size_t)tok * PQW + h * 256;
        float X[64], Y[64];
#pragma unroll
        for (int p = 0; p < 2; ++p) {
            bf16x8 qf[8];
#pragma unroll
            for (int k0 = 0; k0 < 8; ++k0) qf[k0] = *(const GAS bf16x8*)(qrow + p * 128 + k0 * 16 + hi * 8);
#pragma unroll
            for (int kb = 0; kb < 4; ++kb) { f32x16 acc = f32x16{};
                const LAS unsigned char* ap = sk + (p * 128 + kb * 32 + r32) * 272 + hi * 16;
#pragma unroll
                for (int k0 = 0; k0 < 8; ++k0) { const bf16x8 a = *(const LAS bf16x8*)(ap + k0 * 32); acc = __builtin_amdgcn_mfma_f32_32x32x16_bf16(a, qf[k0], acc, 0, 0, 0); }
#pragma unroll
                for (int r = 0; r < 16; ++r) { if (p == 0) X[kb * 16 + r] = acc[r]; else Y[kb * 16 + r] = acc[r]; } }
        }
#pragma unroll
        for (int i = 0; i < 64; ++i) { auto rr = __builtin_amdgcn_permlane32_swap(__float_as_uint(X[i]), __float_as_uint(Y[i]), false, false); X[i] = __uint_as_float(rr[0]); Y[i] = __uint_as_float(rr[1]); }
#pragma unroll
        for (int i = 0; i < 64; ++i) { const unsigned key = 32u * (i >> 4) + (unsigned)((i & 3) + 8 * ((i & 15) >> 2)); X[i] = pack_idx(X[i], key, 127u); Y[i] = pack_idx(Y[i], key + 4u, 127u); }
        float top[16];
        { float g0[16], g1[16];
#pragma unroll
          for (int i = 0; i < 16; ++i) { top[i] = X[i]; g0[i] = X[16 + i]; }
          sort16_desc(top); sort16_desc(g0); merge16_desc(top, g0);
#pragma unroll
          for (int i = 0; i < 16; ++i) { g0[i] = X[32 + i]; g1[i] = X[48 + i]; }
          sort16_desc(g0); sort16_desc(g1); merge16_desc(g0, g1); merge16_desc(top, g0);
#pragma unroll
          for (int i = 0; i < 16; ++i) { g0[i] = Y[i]; g1[i] = Y[16 + i]; }
          sort16_desc(g0); sort16_desc(g1); merge16_desc(g0, g1); merge16_desc(top, g0);
#pragma unroll
          for (int i = 0; i < 16; ++i) { g0[i] = Y[32 + i]; g1[i] = Y[48 + i]; }
          sort16_desc(g0); sort16_desc(g1); merge16_desc(g0, g1); merge16_desc(top, g0); }
        float a[16], b[16];
#pragma unroll
        for (int i = 0; i < 16; ++i) { auto rr = __builtin_amdgcn_permlane32_swap(__float_as_uint(top[i]), __float_as_uint(top[i]), false, false); a[i] = __uint_as_float(rr[0]); b[i] = __uint_as_float(rr[1]); }
        { unsigned wa[4], wb[4];
#pragma unroll
          for (int q = 0; q < 4; ++q) { wa[q] = (__float_as_uint(a[4 * q]) & 127u) | ((__float_as_uint(a[4 * q + 1]) & 127u) << 8) | ((__float_as_uint(a[4 * q + 2]) & 127u) << 16) | ((__float_as_uint(a[4 * q + 3]) & 127u) << 24);
                                         wb[q] = (__float_as_uint(b[4 * q]) & 127u) | ((__float_as_uint(b[4 * q + 1]) & 127u) << 8) | ((__float_as_uint(b[4 * q + 2]) & 127u) << 16) | ((__float_as_uint(b[4 * q + 3]) & 127u) << 24); }
          *(LAS v4u*)ibuf = (v4u){wa[0], wa[1], wa[2], wa[3]}; *(LAS v4u*)(ibuf + 16) = (v4u){wb[0], wb[1], wb[2], wb[3]}; }
        float c0[16], c1[16], c2[16], c3[16];
        { const float NEGI = -INFINITY;
#define CAND(i, j) pack_idx(a[i] + b[j], (unsigned)(((i) << 4) | (j)), 255u)
          c0[0] = CAND(0, 0); c0[1] = CAND(0, 1); c0[2] = CAND(0, 2); c0[3] = CAND(0, 3); c0[4] = CAND(0, 4); c0[5] = CAND(0, 5); c0[6] = CAND(0, 6); c0[7] = CAND(0, 7);
          c0[8] = CAND(0, 8); c0[9] = CAND(0, 9); c0[10] = CAND(0, 10); c0[11] = CAND(0, 11); c0[12] = CAND(0, 12); c0[13] = CAND(0, 13); c0[14] = CAND(0, 14); c0[15] = CAND(0, 15);
          c1[0] = CAND(1, 0); c1[1] = CAND(1, 1); c1[2] = CAND(1, 2); c1[3] = CAND(1, 3); c1[4] = CAND(1, 4); c1[5] = CAND(1, 5); c1[6] = CAND(1, 6); c1[7] = CAND(1, 7);
          c1[8] = CAND(2, 0); c1[9] = CAND(2, 1); c1[10] = CAND(2, 2); c1[11] = CAND(2, 3); c1[12] = CAND(2, 4); c1[13] = CAND(3, 0); c1[14] = CAND(3, 1); c1[15] = CAND(3, 2);
          c2[0] = CAND(3, 3); c2[1] = CAND(4, 0); c2[2] = CAND(4, 1); c2[3] = CAND(4, 2); c2[4] = CAND(5, 0); c2[5] = CAND(5, 1); c2[6] = CAND(6, 0); c2[7] = CAND(6, 1);
          c2[8] = CAND(7, 0); c2[9] = CAND(7, 1); c2[10] = CAND(8, 0); c2[11] = CAND(9, 0); c2[12] = CAND(10, 0); c2[13] = CAND(11, 0); c2[14] = CAND(12, 0); c2[15] = CAND(13, 0);
          c3[0] = CAND(14, 0); c3[1] = CAND(15, 0);
#pragma unroll
          for (int i = 2; i < 16; ++i) c3[i] = NEGI;
#undef CAND
        }
        sort16_desc(c0); sort16_desc(c1); sort16_desc(c2); sort16_desc(c3); merge16_desc(c0, c1); merge16_desc(c2, c3); merge16_desc(c0, c2);
        float e[16], z = 0.f;
#pragma unroll
        for (int i = 0; i < 16; ++i) { e[i] = __expf(c0[i] - c0[0]); z += e[i]; }
        const float iz = 1.0f / z;
        LDS_WAIT();
#pragma unroll
        for (int k = 0; k < 8; ++k) { const float cv = hi ? c0[k + 8] : c0[k]; const float ev = hi ? e[k + 8] : e[k]; const unsigned bits = __float_as_uint(cv);
            const unsigned ia = ibuf[(bits >> 4) & 15u], ib = ibuf[16 + (bits & 15u)];
            const size_t o = (size_t)tok * 128 + h * 16 + k + 8 * hi; IDS[o] = (int)(ia * 128u + ib); GT[o] = ev * iz; }
        LDS_WAIT();
    }
}
typedef float f32x2 __attribute__((ext_vector_type(2)));
__device__ __forceinline__ float dpp_sum16(float x) {
    x += __int_as_float(__builtin_amdgcn_update_dpp(0, __float_as_int(x), 0xB1, 0xf, 0xf, true));
    x += __int_as_float(__builtin_amdgcn_update_dpp(0, __float_as_int(x), 0x4E, 0xf, 0xf, true));
    x += __int_as_float(__builtin_amdgcn_update_dpp(0, __float_as_int(x), 0x141, 0xf, 0xf, true));
    x += __int_as_float(__builtin_amdgcn_update_dpp(0, __float_as_int(x), 0x140, 0xf, 0xf, true));
    return x;
}
__device__ __forceinline__ float gelu_tanh(float x) {
    const float y = 0.7978845608028654f * (x + 0.044715f * x * x * x);
    const float e = __builtin_amdgcn_exp2f(2.0f * 1.4426950408889634f * y);
    const float th = 1.0f - 2.0f * __builtin_amdgcn_rcpf(e + 1.0f);
    return 0.5f * x * (1.0f + th);
}
__device__ __forceinline__ void dot16_fp8(const v4u u, const f32x2 (&h)[8], f32x2& acc) {
    const unsigned w0 = u.x, w1 = u.y, w2 = u.z, w3 = u.w;
    acc = __builtin_elementwise_fma(__builtin_amdgcn_cvt_pk_f32_fp8((int)w0, false), h[0], acc); acc = __builtin_elementwise_fma(__builtin_amdgcn_cvt_pk_f32_fp8((int)w0, true), h[1], acc);
    acc = __builtin_elementwise_fma(__builtin_amdgcn_cvt_pk_f32_fp8((int)w1, false), h[2], acc); acc = __builtin_elementwise_fma(__builtin_amdgcn_cvt_pk_f32_fp8((int)w1, true), h[3], acc);
    acc = __builtin_elementwise_fma(__builtin_amdgcn_cvt_pk_f32_fp8((int)w2, false), h[4], acc); acc = __builtin_elementwise_fma(__builtin_amdgcn_cvt_pk_f32_fp8((int)w2, true), h[5], acc);
    acc = __builtin_elementwise_fma(__builtin_amdgcn_cvt_pk_f32_fp8((int)w3, false), h[6], acc); acc = __builtin_elementwise_fma(__builtin_amdgcn_cvt_pk_f32_fp8((int)w3, true), h[7], acc);
}
__device__ __forceinline__ void axpy16_fp8(const v4u v, const float s, f32x2 (&o)[8]) {
    const unsigned w0 = v.x, w1 = v.y, w2 = v.z, w3 = v.w; const f32x2 ss = {s, s};
    o[0] = __builtin_elementwise_fma(__builtin_amdgcn_cvt_pk_f32_fp8((int)w0, false), ss, o[0]); o[1] = __builtin_elementwise_fma(__builtin_amdgcn_cvt_pk_f32_fp8((int)w0, true), ss, o[1]);
    o[2] = __builtin_elementwise_fma(__builtin_amdgcn_cvt_pk_f32_fp8((int)w1, false), ss, o[2]); o[3] = __builtin_elementwise_fma(__builtin_amdgcn_cvt_pk_f32_fp8((int)w1, true), ss, o[3]);
    o[4] = __builtin_elementwise_fma(__builtin_amdgcn_cvt_pk_f32_fp8((int)w2, false), ss, o[4]); o[5] = __builtin_elementwise_fma(__builtin_amdgcn_cvt_pk_f32_fp8((int)w2, true), ss, o[5]);
    o[6] = __builtin_elementwise_fma(__builtin_amdgcn_cvt_pk_f32_fp8((int)w3, false), ss, o[6]); o[7] = __builtin_elementwise_fma(__builtin_amdgcn_cvt_pk_f32_fp8((int)w3, true), ss, o[7]);
}
__device__ __forceinline__ void peer_phase(Frame& F, const Args& A, int l) {
    const int gw = F.vcu * NWAVES + F.wave, NGW = F.G * NWAVES, lane = F.lane, g = lane >> 4, j = lane & 15;
    const unsigned char* U8 = (const unsigned char*)(A.ws + WS_U) + (size_t)l * NEXP * DM; const unsigned char* V8 = (const unsigned char*)(A.ws + WS_V) + (size_t)l * NEXP * DM;
    const float* SU = (const float*)(A.ws + WS_SU) + (size_t)l * NEXP; const float* SV = (const float*)(A.ws + WS_SV) + (size_t)l * NEXP;
    const bf16* H = (const bf16*)(A.ws + WS_H); bf16* Hn = (bf16*)(A.ws + WS_H);
    const int* IDS = (const int*)(A.ws + WS_IDS); const float* GT = (const float*)(A.ws + WS_GATES);
    const float* mod = (const float*)(A.ws + WS_MOD);
    LAS unsigned* skeys = (LAS unsigned*)(F.lds + F.wave * 2048);
    for (int bt = gw; bt < M / 4; bt += NGW) {
#pragma unroll 1
        for (int tq = 0; tq < 4; ++tq) {
            const int tk = bt * 4 + tq;
            unsigned v0 = ((unsigned)IDS[(size_t)tk * 128 + lane] << 7) | (unsigned)lane, v1 = ((unsigned)IDS[(size_t)tk * 128 + 64 + lane] << 7) | (unsigned)(64 + lane);
#pragma unroll
            for (int k = 2; k <= 128; k <<= 1)
#pragma unroll
                for (int jj = k >> 1; jj > 0; jj >>= 1) {
                    if (jj == 64) { const unsigned lo = min(v0, v1), hi = max(v0, v1); v0 = lo; v1 = hi; }
                    else { const unsigned p0 = (unsigned)__shfl_xor((int)v0, jj), p1 = (unsigned)__shfl_xor((int)v1, jj);
                        const bool lower = (lane & jj) == 0; const bool up0 = ((lane & k) == 0) || (k == 128), up1 = (((lane + 64) & k) == 0) || (k == 128);
                        v0 = (lower == up0) ? min(v0, p0) : max(v0, p0); v1 = (lower == up1) ? min(v1, p1) : max(v1, p1); }
                }
            skeys[tq * 128 + lane] = v0; skeys[tq * 128 + 64 + lane] = v1;
        }
        LDS_WAIT();
        const int tk = bt * 4 + g; const int b = tk / SEQ;
        f32x2 hf[4][8], outv[4][8];
#pragma unroll
        for (int q = 0; q < 4; ++q) { const v4u a = *(const GAS v4u*)(H + (size_t)tk * DM + 256 * q + 16 * j), c = *(const GAS v4u*)(H + (size_t)tk * DM + 256 * q + 16 * j + 8);
            hf[q][0] = (f32x2){bflo(a.x), bfhi(a.x)}; hf[q][1] = (f32x2){bflo(a.y), bfhi(a.y)}; hf[q][2] = (f32x2){bflo(a.z), bfhi(a.z)}; hf[q][3] = (f32x2){bflo(a.w), bfhi(a.w)};
            hf[q][4] = (f32x2){bflo(c.x), bfhi(c.x)}; hf[q][5] = (f32x2){bflo(c.y), bfhi(c.y)}; hf[q][6] = (f32x2){bflo(c.z), bfhi(c.z)}; hf[q][7] = (f32x2){bflo(c.w), bfhi(c.w)};
#pragma unroll
            for (int i = 0; i < 8; ++i) outv[q][i] = (f32x2){0.f, 0.f}; }
        const LAS unsigned* mykeys = skeys + g * 128;
        constexpr int PCH = 2;
#pragma unroll 1
        for (int e = 0; e < 128; e += PCH) {
            unsigned key[PCH];
#pragma unroll
            for (int c = 0; c < PCH; ++c) key[c] = mykeys[e + c];
            v4u buf[PCH][4]; float su[PCH], sv[PCH], gt[PCH];
#pragma unroll
            for (int c = 0; c < PCH; ++c) { const unsigned id = key[c] >> 7; const unsigned char* ur = U8 + (size_t)id * DM + 16 * j;
#pragma unroll
                for (int q = 0; q < 4; ++q) buf[c][q] = *(const GAS v4u*)(ur + 256 * q);
                su[c] = SU[id]; sv[c] = SV[id]; gt[c] = GT[(size_t)tk * 128 + (key[c] & 127u)]; }
            float s[PCH];
#pragma unroll
            for (int c = 0; c < PCH; ++c) { f32x2 acc = {0.f, 0.f};
#pragma unroll
                for (int q = 0; q < 4; ++q) dot16_fp8(buf[c][q], hf[q], acc);
                const unsigned id = key[c] >> 7; const unsigned char* vr = V8 + (size_t)id * DM + 16 * j;
#pragma unroll
                for (int q = 0; q < 4; ++q) buf[c][q] = *(const GAS v4u*)(vr + 256 * q);
                const float d = dpp_sum16(acc.x + acc.y) * su[c];
                s[c] = gt[c] * gelu_tanh(d) * sv[c]; }
#pragma unroll
            for (int c = 0; c < PCH; ++c)
#pragma unroll
                for (int q = 0; q < 4; ++q) axpy16_fp8(buf[c][q], s[c], outv[q]);
        }
        float* xr = A.out + (size_t)tk * DM; const float* g2 = mod + ((size_t)l * NB + b) * 6 * DM + 5 * DM;
        float ss = 0.f;
#pragma unroll
        for (int q = 0; q < 4; ++q)
#pragma unroll
            for (int w = 0; w < 4; ++w) { const int c = 256 * q + 16 * j + 4 * w; const f32x4 x4 = *(const GAS f32x4*)(xr + c), g4 = *(const f32x4*)(g2 + c);
                f32x2 a = outv[q][2 * w], bb = outv[q][2 * w + 1];
                a.x = x4[0] + g4[0] * a.x; a.y = x4[1] + g4[1] * a.y; bb.x = x4[2] + g4[2] * bb.x; bb.y = x4[3] + g4[3] * bb.y;
                ss += (a.x * a.x + a.y * a.y) + (bb.x * bb.x + bb.y * bb.y); outv[q][2 * w] = a; outv[q][2 * w + 1] = bb; }
        const float r = 1.0f / sqrtf(dpp_sum16(ss) * (1.0f / DM) + NORM_EPS);
        if (l == DEPTH - 1) {
            const float* fg = A.in[20];
#pragma unroll
            for (int q = 0; q < 4; ++q)
#pragma unroll
                for (int w = 0; w < 4; ++w) { const int c = 256 * q + 16 * j + 4 * w; const f32x4 g4 = *(const f32x4*)(fg + c); const f32x2 a = outv[q][2 * w], bb = outv[q][2 * w + 1];
                    *(GAS f32x4*)(xr + c) = (f32x4){a.x * r * g4[0], a.y * r * g4[1], bb.x * r * g4[2], bb.y * r * g4[3]}; }
        } else {
            const float* ng = A.in[4] + (size_t)(l + 1) * DM; const float* mn = mod + ((size_t)(l + 1) * NB + b) * 6 * DM;
#pragma unroll
            for (int q = 0; q < 4; ++q) { unsigned pk[8];
#pragma unroll
                for (int w = 0; w < 4; ++w) { const int c = 256 * q + 16 * j + 4 * w; const f32x4 g4 = *(const f32x4*)(ng + c), sc4 = *(const f32x4*)(mn + DM + c), sh4 = *(const f32x4*)(mn + c); const f32x2 a = outv[q][2 * w], bb = outv[q][2 * w + 1];
                    *(GAS f32x4*)(xr + c) = (f32x4){a.x, a.y, bb.x, bb.y};
                    pk[2 * w] = pk2(a.x * r * g4[0] * (1.0f + sc4[0]) + sh4[0], a.y * r * g4[1] * (1.0f + sc4[1]) + sh4[1]);
                    pk[2 * w + 1] = pk2(bb.x * r * g4[2] * (1.0f + sc4[2]) + sh4[2], bb.y * r * g4[3] * (1.0f + sc4[3]) + sh4[3]); }
                *(GAS v4u*)(Hn + (size_t)tk * DM + 256 * q + 16 * j) = (v4u){pk[0], pk[1], pk[2], pk[3]}; *(GAS v4u*)(Hn + (size_t)tk * DM + 256 * q + 16 * j + 8) = (v4u){pk[4], pk[5], pk[6], pk[7]}; }
        }
        LDS_WAIT();
    }
}
__global__ void __launch_bounds__(NWAVES * 64, 2) hybrid_fwd(Args args) {
    extern __shared__ __attribute__((aligned(16))) unsigned char lds[];
    Frame F;
    F.lds = (LAS unsigned char*)lds; F.ldsg = lds;
    F.tid = threadIdx.x; F.lane = F.tid & 63; F.wave = __builtin_amdgcn_readfirstlane(F.tid >> 6);
    F.G = gridDim.x; { const int bx = blockIdx.x; F.vcu = (F.G % 8 == 0) ? (bx % 8) * (F.G / 8) + bx / 8 : bx; }
    volatile LAS unsigned* MISC = (volatile LAS unsigned*)(F.lds + MISC_OFF);
    for (int u = F.tid; u < (LDS_BYTES - LDSCTL_OFF) / 4; u += NWAVES * 64) ((LAS unsigned*)(F.lds + LDSCTL_OFF))[u] = 0u;
    __syncthreads();
    XcdBarrier bar = xcd_barrier_post((unsigned*)(args.ws + WS_CTL) + CW_BAR, MISC + 8);
    const int lo = args.ph_lo, hi = args.ph_hi;
#ifndef TESTPH
#define TESTPH -1
#endif
#define PHON(k) (TESTPH < 0 || TESTPH == (k))
#define IN(k) (lo <= (k) && (k) < hi)
#ifdef DBG_TIME
#define STAMP(ty) do { if (blockIdx.x == 0 && threadIdx.x == 0) { volatile float* tacc_ = (volatile float*)(args.ws + WS_CTL) + 2048 + 16; volatile unsigned long long* tp_ = (volatile unsigned long long*)(args.ws + WS_CTL + 16384); \
      const unsigned long long tn_ = __builtin_amdgcn_s_memrealtime(); const unsigned long long to_ = *tp_; if (to_ != 0ull) tacc_[ty] = tacc_[ty] + (float)(tn_ - to_); *tp_ = tn_; } } while (0)
#else
#define STAMP(ty) do { } while (0)
#endif
#define SEAM(k) do { if ((k) + 1 < hi) xcd_barrier(bar); STAMP(((k) < PH_LAYER0) ? (k) : 2 + ((k) - PH_LAYER0) % PH_PER_LAYER); } while (0)
#define RELANE() do { int t_ = threadIdx.x; asm volatile("" : "+v"(t_)); F.tid = t_; F.lane = t_ & 63; F.wave = __builtin_amdgcn_readfirstlane(t_ >> 6); } while (0)
    STAMP(15);
    if (PHON(100) && IN(PH_PRO_A)) { RELANE(); prologue_a(F, args); SEAM(PH_PRO_A); }
    if (PHON(101) && IN(PH_PRO_B)) { RELANE(); prologue_b(F, args); SEAM(PH_PRO_B); }
    bf16* Hb = (bf16*)(args.ws + WS_H); bf16* PROJ = (bf16*)(args.ws + WS_PROJ);
#pragma unroll 1
    for (int l = 0; l < DEPTH; ++l) {
        const int base = PH_LAYER0 + l * PH_PER_LAYER;
        if (base + PH_PER_LAYER <= lo || base >= hi) continue;
        if (PHON(0) && IN(base + 0)) {
            pg8::Gemm g{Hb, (const bf16*)(args.ws + WS_WIN) + (size_t)l * INW * DM, M, INW, DM}; pg8::StaticOrder S; S.init(M, INW, F.G, (int)blockIdx.x);
            pg8::EpiProj E{PROJ, INW, attn_body::C2};
            pg8::gemm_phase<pg8::EpiProj, pg8::StaticOrder, true, true>(F.lds, g, S, E);
            SEAM(base + 0);
        }
        if (PHON(1) && IN(base + 1)) { RELANE(); attn_phase_all(F, args); SEAM(base + 1); }
        if (PHON(2) && IN(base + 2)) { RELANE(); combine_phase(F, args, l); SEAM(base + 2); }
        if (PHON(3) && IN(base + 3)) {
            { pg8::Gemm g{(const bf16*)(args.ws + WS_OA), (const bf16*)(args.ws + WS_WPA) + (size_t)l * DM * 512, M, DM, 512}; pg8::StaticOrder S; S.init(M, DM, F.G, (int)blockIdx.x);
              pg8::EpiGateMulF32 E{(float*)(args.ws + WS_TMP), DM, PROJ + COL_GA, INW};
              pg8::gemm_phase<pg8::EpiGateMulF32, pg8::StaticOrder, true, true>(F.lds, g, S, E); }
            VM_WAIT(); __syncthreads();
            { pg8::Gemm g{(const bf16*)(args.ws + WS_OB), (const bf16*)(args.ws + WS_WPB) + (size_t)l * DM * DM, M, DM, DM}; pg8::StaticOrder S; S.init(M, DM, F.G, (int)blockIdx.x);
              pg8::EpiGateAddBf16 E{(bf16*)(args.ws + WS_MERGED), (const float*)(args.ws + WS_TMP), DM, PROJ + COL_GB, INW};
              pg8::gemm_phase<pg8::EpiGateAddBf16, pg8::StaticOrder, true, true>(F.lds, g, S, E); }
            SEAM(base + 3);
        }
        if (PHON(4) && IN(base + 4)) {
            pg8::Gemm g{(const bf16*)(args.ws + WS_MERGED), (const bf16*)(args.ws + WS_WO) + (size_t)l * DM * DM, M, DM, DM}; pg8::StaticOrder S; S.init(M, DM, F.G, (int)blockIdx.x);
            pg8::EpiResid E{args.out, DM, (const float*)(args.ws + WS_MOD) + (size_t)l * NB * 6 * DM + 2 * DM, 6 * DM, SEQ};
            pg8::gemm_phase<pg8::EpiResid, pg8::StaticOrder, true, true>(F.lds, g, S, E);
            SEAM(base + 4);
        }
        if (PHON(5) && IN(base + 5)) { RELANE(); norm2_phase(F, args, l); SEAM(base + 5); }
        if (PHON(6) && IN(base + 6)) {
            pg8::Gemm g{Hb, (const bf16*)(args.ws + WS_WQ) + (size_t)l * PQW * DM, M, PQW, DM}; pg8::StaticOrder S; S.init(M, PQW, F.G, (int)blockIdx.x);
            pg8::EpiBf16<0> E{(bf16*)(args.ws + WS_PQ), PQW, nullptr, 0, 0, 1.f};
            pg8::gemm_phase<pg8::EpiBf16<0>, pg8::StaticOrder, true, true>(F.lds, g, S, E);
            SEAM(base + 6);
        }
        if (PHON(7) && IN(base + 7)) { RELANE(); topk_phase(F, args, l); SEAM(base + 7); }
        if (PHON(8) && IN(base + 8)) { RELANE(); peer_phase(F, args, l); SEAM(base + 8); }
    }
#undef IN
#undef SEAM
}


#ifdef DBG_CHECK
__global__ void __launch_bounds__(256) dbg_k1(Args A, int l) {
    float* dw = (float*)(A.ws + WS_CTL) + 2048;
    const int g = blockIdx.x * 256 + threadIdx.x;
    const bf16* PQ = (const bf16*)(A.ws + WS_PQ); const bf16* SK = (const bf16*)(A.ws + WS_SUBK) + (size_t)l * 2 * 128 * 128;
    const int* IDS = (const int*)(A.ws + WS_IDS); const float* GT = (const float*)(A.ws + WS_GATES);
    if (g < 2048) {
        float* scr = (float*)(A.ws + WS_DBG) + (size_t)g * 512;
        const int tok = g * 8; float miss = 0.f, gerr = 0.f;
        for (int h = 0; h < 8; ++h) {
            for (int p = 0; p < 2; ++p)
                for (int k = 0; k < 128; ++k) { float s = 0.f;
                    for (int d = 0; d < 128; ++d) s += bflo((unsigned)PQ[(size_t)tok * PQW + h * 256 + p * 128 + d]) * bflo((unsigned)SK[(p * 128 + k) * 128 + d]);
                    scr[p * 128 + k] = s; }
            for (int p = 0; p < 2; ++p)
                for (int i = 0; i < 16; ++i) { float best = -INFINITY; int bi = 0;
                    for (int k = 0; k < 128; ++k) { const float v = scr[p * 128 + k]; if (v > best) { best = v; bi = k; } }
                    scr[256 + p * 32 + i] = best; scr[256 + p * 32 + 16 + i] = (float)bi; scr[p * 128 + bi] = -INFINITY; }
            for (int i = 0; i < 16; ++i) for (int j = 0; j < 16; ++j) scr[i * 16 + j] = scr[256 + i] + scr[256 + 32 + j];
            for (int i = 0; i < 16; ++i) { float best = -INFINITY; int bi = 0;
                for (int k = 0; k < 256; ++k) { const float v = scr[k]; if (v > best) { best = v; bi = k; } }
                scr[384 + i] = best; scr[400 + i] = (float)((int)scr[256 + 16 + (bi >> 4)] * 128 + (int)scr[256 + 32 + 16 + (bi & 15)]); scr[bi] = -INFINITY; }
            float z = 0.f; const float b0 = scr[384];
            for (int i = 0; i < 16; ++i) z += __expf(scr[384 + i] - b0);
            for (int i = 0; i < 16; ++i) { const float gi = __expf(scr[384 + i] - b0) / z; const int myid = (int)scr[400 + i]; bool found = false;
                for (int k = 0; k < 16; ++k) { if (IDS[(size_t)tok * 128 + h * 16 + k] == myid) { found = true; gerr += fabsf(GT[(size_t)tok * 128 + h * 16 + k] - gi); } }
                if (!found) miss += 1.f; }
        }
        atomicAdd(dw + 0, miss); atomicAdd(dw + 1, gerr);
    }
    __shared__ float red[256]; __shared__ float sdot;
    if (blockIdx.x < 256) {
        const int tk = blockIdx.x * 64, t = threadIdx.x; const bf16* H = (const bf16*)(A.ws + WS_H) + (size_t)tk * DM;
        const float* Uf = A.in[18] + (size_t)l * NEXP * DM; const float* Vf = A.in[19] + (size_t)l * NEXP * DM;
        float hf[4], on[4] = {0.f, 0.f, 0.f, 0.f};
        for (int i = 0; i < 4; ++i) hf[i] = bflo((unsigned)H[4 * t + i]);
        for (int e = 0; e < 128; ++e) { const int id = IDS[(size_t)tk * 128 + e]; const float gt = GT[(size_t)tk * 128 + e];
            float d = 0.f; for (int i = 0; i < 4; ++i) d += hf[i] * Uf[(size_t)id * DM + 4 * t + i];
            red[t] = d; __syncthreads();
            if (t == 0) { float s = 0.f; for (int i = 0; i < 256; ++i) s += red[i]; sdot = s; }
            __syncthreads();
            const float dd = sdot; const float act = 0.5f * dd * (1.0f + tanhf(0.7978845608028654f * (dd + 0.044715f * dd * dd * dd))); const float s = gt * act;
            for (int i = 0; i < 4; ++i) on[i] += s * Vf[(size_t)id * DM + 4 * t + i];
            __syncthreads(); }
        float* nb = (float*)(A.ws + WS_DBG) + (size_t)(5 << 20) + (size_t)blockIdx.x * DM;
        for (int i = 0; i < 4; ++i) nb[4 * t + i] = on[i];
    }
}
__global__ void __launch_bounds__(256) dbg_k2a(Args A) {
    float* dw = (float*)(A.ws + WS_CTL) + 2048;
    const float* fb = (const float*)(A.ws + WS_DBG) + (size_t)(4 << 20) + (size_t)blockIdx.x * DM; const float* nb = (const float*)(A.ws + WS_DBG) + (size_t)(5 << 20) + (size_t)blockIdx.x * DM;
    float num = 0.f, den = 0.f;
    for (int i = threadIdx.x; i < DM; i += 256) { const float d = fb[i] - nb[i]; num += d * d; den += nb[i] * nb[i]; }
    atomicAdd(dw + 2, num); atomicAdd(dw + 3, den);
}
__global__ void __launch_bounds__(256) dbg_k2b(Args A) {
    const float* dw = (const float*)(A.ws + WS_CTL) + 2048; float Dv;
    if (DBG_CHECK == 1) Dv = dw[0] * (1.0f / 262144.0f); else if (DBG_CHECK == 2) Dv = dw[1] * (1.0f / 262144.0f); else Dv = sqrtf(dw[2] / fmaxf(dw[3], 1e-30f));
    const float al = 1.0f + 100.0f * Dv;
    for (size_t i = (size_t)blockIdx.x * 256 + threadIdx.x; i < (size_t)M * DM; i += (size_t)gridDim.x * 256) A.out[i] *= al;
}
#endif
extern "C" void kernel_launch(void* const* d_in, const int* in_sizes, int n_in, void* d_out, int out_size, void* d_ws, size_t ws_size, hipStream_t stream) {
    static int grid = 0;
    if (grid == 0) {
        if (n_in != 21 || out_size != M * DM || ws_size < WS_END) { fprintf(stderr, "kernel_launch: unexpected problem (n_in %d, out %d, ws %zu)\n", n_in, out_size, ws_size); grid = -1; return; }
        int dev = 0, cus = 0, per_cu = 0;
        if (hipGetDevice(&dev) != hipSuccess || hipDeviceGetAttribute(&cus, hipDeviceAttributeMultiprocessorCount, dev) != hipSuccess) { grid = -1; return; }
        if (hipFuncSetAttribute((const void*)hybrid_fwd, hipFuncAttributeMaxDynamicSharedMemorySize, LDS_BYTES) != hipSuccess) { fprintf(stderr, "kernel_launch: hipFuncSetAttribute failed\n"); grid = -1; return; }
        if (hipOccupancyMaxActiveBlocksPerMultiprocessor(&per_cu, (const void*)hybrid_fwd, NWAVES * 64, LDS_BYTES) != hipSuccess || per_cu < 1) fprintf(stderr, "kernel_launch: occupancy query reports %d\n", per_cu);
        (void)hipGetLastError();
        grid = cus;
    }
    if (grid < 0) return;
    (void)hipMemsetAsync((char*)d_ws + WS_CTL, 0, CTL_ZERO_BYTES, stream);
    Args a{};
    for (int i = 0; i < 21; ++i) a.in[i] = (const float*)d_in[i];
    a.out = (float*)d_out; a.ws = (unsigned char*)d_ws;
#if MK_PER_PHASE
    for (int p = 0; p < NPHASE; ++p) { a.ph_lo = p; a.ph_hi = p + 1;
#ifdef DBG_CHECK
        if (p == PH_LAYER0 + 8) hipLaunchKernelGGL(dbg_k1, dim3(256), dim3(256), 0, stream, a, 0);
#endif
        hipLaunchKernelGGL(hybrid_fwd, dim3(grid), dim3(NWAVES * 64), LDS_BYTES, stream, a); }
#ifdef DBG_CHECK
    hipLaunchKernelGGL(dbg_k2a, dim3(256), dim3(256), 0, stream, a);
    hipLaunchKernelGGL(dbg_k2b, dim3(1024), dim3(256), 0, stream, a);
#endif
#else
    a.ph_lo = 0; a.ph_hi = NPHASE;
    hipLaunchKernelGGL(hybrid_fwd, dim3(grid), dim3(NWAVES * 64), LDS_BYTES, stream, a);
#endif
}
```

```cpp
#include <hip/hip_runtime.h>
#include <hip/hip_bf16.h>
#include <cstdio>
#include <cstdint>
#include <cmath>
#ifndef MK_PER_PHASE
#define MK_PER_PHASE 0
#endif
namespace pg8 {
#define PG8_LAS __attribute__((address_space(3)))
typedef unsigned short bf16_t;
typedef short bf16x8 __attribute__((ext_vector_type(8)));
typedef float f32x4 __attribute__((ext_vector_type(4)));
typedef unsigned u32x4 __attribute__((ext_vector_type(4)));
constexpr int BM = 256, BK = 64, HALF = 128, HTB = HALF * BK * 2  , STAGE_BYTES = 8 * HTB, NXCD = 8, WGM = 8;

__host__ __device__ __forceinline__ int lds_byte(int r, int c) { const int st = (r >> 4) * 2 + (c >> 5), rr = r & 15, cc = c & 31, ob = rr * 64 + cc * 2; return st * 1024 + (ob ^ (((ob >> 9) & 1) << 5)); }
__host__ __device__ __forceinline__ void stage_rc(int b, int& R, int& C) { const int st = b / 1024, sb = b % 1024, swz = sb ^ (((sb >> 9) & 1) << 5); R = (st >> 1) * 16 + swz / 64; C = (st & 1) * 32 + (swz % 64) / 2; }
__host__ __device__ __forceinline__ int perm32(int rho) { const int n = rho >> 4, i = rho & 15; return 8 * (i >> 2) + 4 * n + (i & 3); }

struct Unit { int pm, pn; };
struct Gemm { const bf16_t* A; const bf16_t* Bt; int M, N, K; };

struct StaticOrder {
    int nM, nN, nwg, G, c;
    __host__ __device__ void init(int M, int N, int G_, int c_) { nM = M / BM; nN = N / BM; nwg = nM * nN; G = G_; c = c_; }
    __host__ __device__ bool next(int i, Unit& u) const {
        const long L = (long)i * G + c; if (L >= nwg) return false;
        int wgid = (int)L; { const int q = nwg / NXCD, r = nwg % NXCD, xcd = wgid % NXCD, off = wgid / NXCD; wgid = (xcd < r ? xcd * (q + 1) : r * (q + 1) + (xcd - r) * q) + off; }
        const int nig = WGM * nN, gid = wgid / nig, fm = gid * WGM, gsz = (nM - fm) < WGM ? (nM - fm) : WGM;
        u.pm = fm + ((wgid % nig) % gsz); u.pn = (wgid % nig) / gsz; return true;
    }
    __device__ __forceinline__ void a_ready(const Unit&) const {}
    __device__ __forceinline__ void done(const Unit&) const {}
};

__device__ __forceinline__ unsigned cvt_pk_bf16(float lo, float hi) { unsigned r; asm volatile("v_cvt_pk_bf16_f32 %0, %1, %2" : "=v"(r) : "v"(lo), "v"(hi)); return r; }
typedef float f32x2 __attribute__((ext_vector_type(2)));
__device__ __forceinline__ f32x2 gelu_pk(f32x2 v) {
    const f32x2 av = __builtin_elementwise_abs(v), d = av * 0.2316418882f + 1.0f;
    f32x2 t; t.x = __builtin_amdgcn_rcpf(d.x); t.y = __builtin_amdgcn_rcpf(d.y);
    f32x2 q = t * 0.5307027145f + (-0.7265760135f); q = q * t + 0.7107068705f; q = q * t + (-0.142248368f); q = q * t + 0.127414796f; q = q * t;
    const f32x2 s = (v * v) * (-0.72134752044f);
    f32x2 e; e.x = __builtin_amdgcn_exp2f(s.x); e.y = __builtin_amdgcn_exp2f(s.y);
    const f32x2 m = v * (q * e), r = v - m;
    f32x2 o; o.x = v.x < 0.f ? m.x : r.x; o.y = v.y < 0.f ? m.y : r.y; return o;
}

template <int ACT  > struct EpiBf16 {
    static constexpr bool PERM = true, AFTER_DRAIN = false; static_assert(ACT == 0 || ACT == 1, "EpiBf16: ACT is 0 (none) or 1 (gelu_pk)");
    bf16_t* O; int ldc; const float* bias; int split_cols; size_t split_stride; float scale0;
    __device__ __forceinline__ void operator()(const f32x4 (&acc)[2][2][4][2], const Unit& u, int wr, int wc, int fr, int fq) const {
        const int row0 = u.pm * BM + wr * 64 + fr; int colt = u.pn * BM; bf16_t* base = O;
        float sc = 1.f; if (split_cols) { const int t = colt / split_cols; base += (size_t)t * split_stride; colt -= t * split_cols; if (t == 0) sc = scale0; }
        const int col0 = colt + wc * 32 + 8 * fq, bcol0 = u.pn * BM + wc * 32 + 8 * fq;
        f32x4 bv[2][2];
#pragma unroll
        for (int bj = 0; bj < 2; ++bj)
#pragma unroll
            for (int n = 0; n < 2; ++n) bv[bj][n] = bias ? *(const f32x4*)(bias + bcol0 + bj * HALF + 4 * n) : (f32x4){0.f, 0.f, 0.f, 0.f};
#pragma unroll
        for (int ai = 0; ai < 2; ++ai)
#pragma unroll
            for (int m = 0; m < 4; ++m) { bf16_t* rowp = base + (size_t)(row0 + ai * HALF + m * 16) * ldc + col0;
#pragma unroll
                for (int bj = 0; bj < 2; ++bj) { f32x4 v0 = acc[ai][bj][m][0] + bv[bj][0], v1 = acc[ai][bj][m][1] + bv[bj][1];
                    if (ACT == 1) { f32x2 a = gelu_pk((f32x2){v0[0], v0[1]}), b = gelu_pk((f32x2){v0[2], v0[3]}), c = gelu_pk((f32x2){v1[0], v1[1]}), d = gelu_pk((f32x2){v1[2], v1[3]});
                        v0 = (f32x4){a.x, a.y, b.x, b.y}; v1 = (f32x4){c.x, c.y, d.x, d.y}; }
                    v0 = v0 * sc; v1 = v1 * sc; u32x4 w; w.x = cvt_pk_bf16(v0[0], v0[1]); w.y = cvt_pk_bf16(v0[2], v0[3]); w.z = cvt_pk_bf16(v1[0], v1[1]); w.w = cvt_pk_bf16(v1[2], v1[3]);
                    *(u32x4*)(rowp + bj * HALF) = w; } }
    }
};
typedef unsigned u32x2 __attribute__((ext_vector_type(2)));
__device__ __forceinline__ float bf_lo(unsigned w) { return __uint_as_float(w << 16); }
__device__ __forceinline__ float bf_hi(unsigned w) { return __uint_as_float(w & 0xffff0000u); }
__device__ __forceinline__ float sigmoidf_fast(float v) { return __builtin_amdgcn_rcpf(1.0f + __builtin_amdgcn_exp2f(-1.4426950408889634f * v)); }
struct EpiProj {
    static constexpr bool PERM = true, AFTER_DRAIN = false;
    bf16_t* O; int ldc; float c2;
    __device__ __forceinline__ void operator()(const f32x4 (&acc)[2][2][4][2], const Unit& u, int wr, int wc, int fr, int fq) const {
        const int row0 = u.pm * BM + wr * 64 + fr, col0 = u.pn * BM + wc * 32 + 8 * fq;
        const bool isq = (u.pn < 6) || (u.pn >= 18 && u.pn < 22), isg = (u.pn >= 30);
        const float sc = isq ? c2 : 1.0f;
#pragma unroll
        for (int ai = 0; ai < 2; ++ai)
#pragma unroll
            for (int m = 0; m < 4; ++m) { bf16_t* rowp = O + (size_t)(row0 + ai * HALF + m * 16) * ldc + col0;
#pragma unroll
                for (int bj = 0; bj < 2; ++bj) { f32x4 v0 = acc[ai][bj][m][0], v1 = acc[ai][bj][m][1];
                    if (isg) { v0 = (f32x4){sigmoidf_fast(v0[0]), sigmoidf_fast(v0[1]), sigmoidf_fast(v0[2]), sigmoidf_fast(v0[3])}; v1 = (f32x4){sigmoidf_fast(v1[0]), sigmoidf_fast(v1[1]), sigmoidf_fast(v1[2]), sigmoidf_fast(v1[3])}; }
                    else { v0 = v0 * sc; v1 = v1 * sc; }
                    u32x4 w; w.x = cvt_pk_bf16(v0[0], v0[1]); w.y = cvt_pk_bf16(v0[2], v0[3]); w.z = cvt_pk_bf16(v1[0], v1[1]); w.w = cvt_pk_bf16(v1[2], v1[3]);
                    *(u32x4*)(rowp + bj * HALF) = w; } }
    }
};
struct EpiGateMulF32 {
    static constexpr bool PERM = true, AFTER_DRAIN = false;
    float* T; int ldc; const bf16_t* G; int ldg;
    __device__ __forceinline__ void operator()(const f32x4 (&acc)[2][2][4][2], const Unit& u, int wr, int wc, int fr, int fq) const {
        const int row0 = u.pm * BM + wr * 64 + fr, col0 = u.pn * BM + wc * 32 + 8 * fq;
#pragma unroll
        for (int ai = 0; ai < 2; ++ai)
#pragma unroll
            for (int m = 0; m < 4; ++m) { const size_t row = (size_t)(row0 + ai * HALF + m * 16);
#pragma unroll
                for (int bj = 0; bj < 2; ++bj) { const int c = col0 + bj * HALF; const u32x4 g = *(const u32x4*)(G + row * ldg + c);
                    f32x4 v0 = acc[ai][bj][m][0], v1 = acc[ai][bj][m][1];
                    v0 = v0 * (f32x4){bf_lo(g.x), bf_hi(g.x), bf_lo(g.y), bf_hi(g.y)}; v1 = v1 * (f32x4){bf_lo(g.z), bf_hi(g.z), bf_lo(g.w), bf_hi(g.w)};
                    *(f32x4*)(T + row * ldc + c) = v0; *(f32x4*)(T + row * ldc + c + 4) = v1; } }
    }
};
struct EpiGateAddBf16 {
    static constexpr bool PERM = true, AFTER_DRAIN = false;
    bf16_t* O; const float* T; int ldc; const bf16_t* G; int ldg;
    __device__ __forceinline__ void operator()(const f32x4 (&acc)[2][2][4][2], const Unit& u, int wr, int wc, int fr, int fq) const {
        const int row0 = u.pm * BM + wr * 64 + fr, col0 = u.pn * BM + wc * 32 + 8 * fq;
#pragma unroll
        for (int ai = 0; ai < 2; ++ai)
#pragma unroll
            for (int m = 0; m < 4; ++m) { const size_t row = (size_t)(row0 + ai * HALF + m * 16);
#pragma unroll
                for (int bj = 0; bj < 2; ++bj) { const int c = col0 + bj * HALF; const u32x4 g = *(const u32x4*)(G + row * ldg + c);
                    const f32x4 t0 = *(const f32x4*)(T + row * ldc + c), t1 = *(const f32x4*)(T + row * ldc + c + 4);
                    f32x4 v0 = acc[ai][bj][m][0], v1 = acc[ai][bj][m][1];
                    v0 = t0 + v0 * (f32x4){bf_lo(g.x), bf_hi(g.x), bf_lo(g.y), bf_hi(g.y)}; v1 = t1 + v1 * (f32x4){bf_lo(g.z), bf_hi(g.z), bf_lo(g.w), bf_hi(g.w)};
                    u32x4 w; w.x = cvt_pk_bf16(v0[0], v0[1]); w.y = cvt_pk_bf16(v0[2], v0[3]); w.z = cvt_pk_bf16(v1[0], v1[1]); w.w = cvt_pk_bf16(v1[2], v1[3]);
                    *(u32x4*)(O + row * ldc + c) = w; } }
    }
};
struct EpiResid {
    static constexpr bool PERM = true, AFTER_DRAIN = false;
    float* X; int ldc; const float* gvec; int gstride; int rows_per_batch;
    __device__ __forceinline__ void operator()(const f32x4 (&acc)[2][2][4][2], const Unit& u, int wr, int wc, int fr, int fq) const {
        const int row0 = u.pm * BM + wr * 64 + fr, col0 = u.pn * BM + wc * 32 + 8 * fq;
        const float* gv = gvec + (size_t)((u.pm * BM) / rows_per_batch) * gstride;
        f32x4 g0[2], g1[2];
#pragma unroll
        for (int bj = 0; bj < 2; ++bj) { g0[bj] = *(const f32x4*)(gv + col0 + bj * HALF); g1[bj] = *(const f32x4*)(gv + col0 + bj * HALF + 4); }
#pragma unroll
        for (int ai = 0; ai < 2; ++ai)
#pragma unroll
            for (int m = 0; m < 4; ++m) { const size_t row = (size_t)(row0 + ai * HALF + m * 16);
#pragma unroll
                for (int bj = 0; bj < 2; ++bj) { float* p = X + row * ldc + col0 + bj * HALF;
                    const f32x4 x0 = *(const f32x4*)p, x1 = *(const f32x4*)(p + 4);
                    #ifdef DBG_SKIP_MIX
                    *(f32x4*)p = x0; *(f32x4*)(p + 4) = x1; } }
#else
                    *(f32x4*)p = x0 + g0[bj] * acc[ai][bj][m][0]; *(f32x4*)(p + 4) = x1 + g1[bj] * acc[ai][bj][m][1]; } }
#endif
    }
};
template <class Epi, class Sched, bool ALIGN_EPI = false, bool SP2 = false>
__device__ __forceinline__ void gemm_phase(PG8_LAS unsigned char* lds, const Gemm g, const Sched& S, const Epi& E) {
    int tid_ = threadIdx.x; asm volatile("" : "+v"(tid_));
    const int tid = tid_, wid = __builtin_amdgcn_readfirstlane(tid >> 6), lane = tid & 63, wr = wid >> 2, wc = wid & 3, fr = lane & 15, fq = lane >> 4;
    const int K = g.K, nt = K / BK;
    unsigned voffA[2], voffB[2];
#pragma unroll
    for (int i = 0; i < 2; ++i) { int R, C; stage_rc(tid * 16 + i * 8192, R, C); const int Rb = Epi::PERM ? ((R & ~31) + perm32(R & 31)) : R;
        voffA[i] = (unsigned)(R * K + C) * 2u; voffB[i] = (unsigned)(Rb * K + C) * 2u; }
    const size_t kstep = (size_t)(BK * 2);
    const size_t hstep = (size_t)HALF * K * 2;
    const size_t tstep = 2 * hstep;
    const unsigned ldsw = (unsigned)wid * 1024u;
    const int aoff = lds_byte(wr * 64 + fr, fq * 8), boff = lds_byte(wc * 32 + fr, fq * 8);
#define PG8_SA(b, h) (((b) * 2 + (h)) * HTB)
#define PG8_SB(b, h) ((4 + (b) * 2 + (h)) * HTB)
#define PG8_STAGE(bufoff, gbase, voff) do { _Pragma("unroll") for (int _i = 0; _i < 2; ++_i) \
        __builtin_amdgcn_global_load_lds((const unsigned*)((const char*)(gbase) + (voff)[_i]), (PG8_LAS unsigned*)(lds + (bufoff) + ldsw + _i * 8192), 16, 0, 0); } while (0)
#define PG8_LDA(dst, b, h) do { _Pragma("unroll") for (int m = 0; m < 4; ++m) _Pragma("unroll") for (int k = 0; k < 2; ++k) dst[m][k] = *(const PG8_LAS bf16x8*)(lds + PG8_SA(b, h) + aoff + m * 2048 + k * 1024); } while (0)
#define PG8_LDB(dst, b, h) do { _Pragma("unroll") for (int n = 0; n < 2; ++n) _Pragma("unroll") for (int k = 0; k < 2; ++k) dst[n][k] = *(const PG8_LAS bf16x8*)(lds + PG8_SB(b, h) + boff + n * 2048 + k * 1024); } while (0)
#define PG8_MMA(ai, bj, At, Bt) do { __builtin_amdgcn_s_setprio(1); _Pragma("unroll") for (int m = 0; m < 4; ++m) _Pragma("unroll") for (int n = 0; n < 2; ++n) _Pragma("unroll") for (int k = 0; k < 2; ++k) \
        acc[ai][bj][m][n] = __builtin_amdgcn_mfma_f32_16x16x32_bf16(Bt[n][k], At[m][k], acc[ai][bj][m][n], 0, 0, 0); __builtin_amdgcn_s_setprio(0); } while (0)
#define PG8_WAIT_V(n) asm volatile("s_waitcnt vmcnt(" #n ")" ::: "memory")
#define PG8_WAIT_L(n) asm volatile("s_waitcnt lgkmcnt(" #n ")" ::: "memory")
#define PG8_BAR __builtin_amdgcn_s_barrier()
#define PG8_SCHED __builtin_amdgcn_sched_barrier(0)
    Unit cur, nxt; int ui = 0;
    if (!S.next(0, cur)) return;
    f32x4 acc[2][2][4][2];
#pragma unroll
    for (int a = 0; a < 2; ++a)
#pragma unroll
        for (int b = 0; b < 2; ++b)
#pragma unroll
            for (int m = 0; m < 4; ++m)
#pragma unroll
                for (int n = 0; n < 2; ++n) acc[a][b][m][n] = (f32x4){0.f, 0.f, 0.f, 0.f};
    bf16x8 At[4][2], B0[2][2], B1[2][2];
    const char* cA = (const char*)g.A + (size_t)cur.pm * tstep; const char* cB = (const char*)g.Bt + (size_t)cur.pn * tstep;
    S.a_ready(cur);
    if constexpr (SP2) {
        PG8_STAGE(PG8_SB(0, 0), cB, voffB); PG8_STAGE(PG8_SB(0, 1), cB + hstep, voffB); PG8_STAGE(PG8_SA(0, 0), cA, voffA); PG8_STAGE(PG8_SA(0, 1), cA + hstep, voffA);
        if (wr == 1) PG8_BAR;
        PG8_WAIT_V(2); PG8_BAR;
        PG8_STAGE(PG8_SB(1, 0), cB + kstep, voffB); PG8_STAGE(PG8_SA(1, 0), cA + kstep, voffA); PG8_STAGE(PG8_SB(1, 1), cB + hstep + kstep, voffB);
        PG8_WAIT_V(6); PG8_BAR;
    } else {
        PG8_STAGE(PG8_SB(0, 0), cB, voffB); PG8_STAGE(PG8_SA(0, 0), cA, voffA); PG8_STAGE(PG8_SB(0, 1), cB + hstep, voffB); PG8_STAGE(PG8_SA(0, 1), cA + hstep, voffA);
        if (wr == 1) PG8_BAR;
        PG8_WAIT_V(4); PG8_BAR;
        PG8_STAGE(PG8_SB(1, 0), cB + kstep, voffB); PG8_STAGE(PG8_SA(1, 0), cA + kstep, voffA); PG8_STAGE(PG8_SB(1, 1), cB + hstep + kstep, voffB);
        PG8_WAIT_V(6); PG8_BAR;
    }
    for (;;) {
        const bool has_next = S.next(ui + 1, nxt);
        const char* nA = has_next ? (const char*)g.A + (size_t)nxt.pm * tstep : cA; const char* nB = has_next ? (const char*)g.Bt + (size_t)nxt.pn * tstep : cB;
        for (int t = 0; t < nt; t += 2) {
            const bool last = (t == nt - 2);
            const char* a1 = cA + (size_t)(t + 1) * kstep;
            const char* a2 = last ? nA : cA + (size_t)(t + 2) * kstep; const char* b2 = last ? nB : cB + (size_t)(t + 2) * kstep;
            const char* a3 = a2 + kstep; const char* b3 = b2 + kstep;
            if (last && has_next) S.a_ready(nxt);
            if constexpr (SP2) {
            PG8_LDB(B0, 0, 0); PG8_LDB(B1, 0, 1); PG8_SCHED; PG8_LDA(At, 0, 0); PG8_STAGE(PG8_SA(1, 1), a1 + hstep, voffA);
            PG8_WAIT_V(8); PG8_WAIT_L(0); PG8_BAR; PG8_MMA(0, 0, At, B0); PG8_MMA(0, 1, At, B1); PG8_BAR; PG8_SCHED;
            PG8_LDA(At, 0, 1); PG8_STAGE(PG8_SB(0, 0), b2, voffB); PG8_STAGE(PG8_SB(0, 1), b2 + hstep, voffB); PG8_STAGE(PG8_SA(0, 0), a2, voffA);
            PG8_WAIT_V(8); PG8_WAIT_L(0); PG8_BAR; PG8_MMA(1, 0, At, B0); PG8_MMA(1, 1, At, B1); PG8_BAR; PG8_SCHED;
            PG8_LDB(B0, 1, 0); PG8_LDB(B1, 1, 1); PG8_SCHED; PG8_LDA(At, 1, 0); PG8_STAGE(PG8_SA(0, 1), a2 + hstep, voffA);
            PG8_WAIT_V(8); PG8_WAIT_L(0); PG8_BAR; PG8_MMA(0, 0, At, B0); PG8_MMA(0, 1, At, B1); PG8_BAR; PG8_SCHED;
            PG8_LDA(At, 1, 1); PG8_STAGE(PG8_SB(1, 0), b3, voffB); PG8_STAGE(PG8_SB(1, 1), b3 + hstep, voffB); PG8_STAGE(PG8_SA(1, 0), a3, voffA);
            PG8_WAIT_V(8); PG8_WAIT_L(0); PG8_BAR; PG8_MMA(1, 0, At, B0); PG8_MMA(1, 1, At, B1); PG8_BAR; PG8_SCHED;
            } else {
            PG8_LDB(B0, 0, 0); PG8_SCHED; PG8_LDA(At, 0, 0); PG8_STAGE(PG8_SA(1, 1), a1 + hstep, voffA);
            PG8_WAIT_L(8); PG8_BAR; PG8_WAIT_L(0); PG8_MMA(0, 0, At, B0); PG8_BAR; PG8_SCHED;
            PG8_LDB(B1, 0, 1); PG8_STAGE(PG8_SB(0, 0), b2, voffB);
            PG8_BAR; PG8_WAIT_L(0); PG8_MMA(0, 1, At, B1); PG8_BAR;
            PG8_LDA(At, 0, 1); PG8_STAGE(PG8_SA(0, 0), a2, voffA);
            PG8_BAR; PG8_WAIT_L(0); PG8_MMA(1, 0, At, B0); PG8_BAR; PG8_SCHED;
            PG8_STAGE(PG8_SB(0, 1), b2 + hstep, voffB);
            PG8_WAIT_V(6); PG8_BAR; PG8_MMA(1, 1, At, B1); PG8_BAR;
            PG8_LDB(B0, 1, 0); PG8_SCHED; PG8_LDA(At, 1, 0); PG8_STAGE(PG8_SA(0, 1), a2 + hstep, voffA);
            PG8_WAIT_L(8); PG8_BAR; PG8_WAIT_L(0); PG8_MMA(0, 0, At, B0); PG8_BAR; PG8_SCHED;
            PG8_LDB(B1, 1, 1); PG8_STAGE(PG8_SB(1, 0), b3, voffB);
            PG8_BAR; PG8_WAIT_L(0); PG8_MMA(0, 1, At, B1); PG8_BAR;
            PG8_LDA(At, 1, 1); PG8_STAGE(PG8_SA(1, 0), a3, voffA);
            PG8_BAR; PG8_WAIT_L(0); PG8_MMA(1, 0, At, B0); PG8_BAR; PG8_SCHED;
            PG8_STAGE(PG8_SB(1, 1), b3 + hstep, voffB);
            PG8_WAIT_V(6); PG8_BAR; PG8_MMA(1, 1, At, B1); PG8_BAR;
            }
        }
        if constexpr (ALIGN_EPI) { if (wr == 0) PG8_BAR; }
        if constexpr (!Epi::AFTER_DRAIN) { E(acc, cur, wr, wc, fr, fq); S.done(cur); }
        if (!has_next) break;
#pragma unroll
        for (int a = 0; a < 2; ++a)
#pragma unroll
            for (int b = 0; b < 2; ++b)
#pragma unroll
                for (int m = 0; m < 4; ++m)
#pragma unroll
                    for (int n = 0; n < 2; ++n) acc[a][b][m][n] = (f32x4){0.f, 0.f, 0.f, 0.f};
        cur = nxt; cA = nA; cB = nB; ++ui;
        if constexpr (ALIGN_EPI) { if (wr == 1) PG8_BAR; }
    }
    PG8_WAIT_V(0);
    if constexpr (!ALIGN_EPI) { if (wr == 0) PG8_BAR; }
    PG8_BAR;
    if constexpr (Epi::AFTER_DRAIN) { E.fused(acc, cur, wr, wc, fr, fq, lds, wid, lane); S.done(cur); }
#undef PG8_SA
#undef PG8_SB
#undef PG8_STAGE
#undef PG8_LDA
#undef PG8_LDB
#undef PG8_MMA
#undef PG8_WAIT_V
#undef PG8_WAIT_L
#undef PG8_BAR
#undef PG8_SCHED
}
}
#include <hip/hip_bf16.h>
namespace attn_body {
using bf16=__hip_bfloat16;
using bf16x8=__attribute__((ext_vector_type(8)))short;
using s16x4=__attribute__((ext_vector_type(4)))short;
using f32x16=__attribute__((ext_vector_type(16)))float;
using u32x4=__attribute__((ext_vector_type(4)))unsigned;
constexpr int D=64;
constexpr int NW=8,QBLK=32,QB=QBLK*NW,KVBLK=64;
__device__ __forceinline__ int crow(int r,int hi){return (r&3)+8*(r>>2)+4*hi;}
#define SBAR() __builtin_amdgcn_sched_barrier(0)
__device__ __forceinline__ void cmask(f32x16&p0,f32x16&p1,int jb,int qrel,int hi){
  const float NEG=-INFINITY; int kb=64*jb+4*hi;
  #pragma unroll
  for(int r=0;r<16;++r){int kv=kb+(r&3)+8*(r>>2); if(kv>qrel)p0[r]=NEG; if(kv+32>qrel)p1[r]=NEG;}
}
__device__ __forceinline__ void wmask(f32x16&p0,f32x16&p1,int kb0,int qrel,int hi,int W,int PM){
  const float NEG=-INFINITY; const int d0=qrel-kb0-4*hi;
  #pragma unroll
  for(int r=0;r<16;++r){const int d=d0-((r&3)+8*(r>>2)); const int e=d-32;
    if(!(((unsigned)d<=(unsigned)W)&&((d&PM)==0)))p0[r]=NEG;
    if(!(((unsigned)e<=(unsigned)W)&&((e&PM)==0)))p1[r]=NEG;}
}
constexpr int NSLOT=3, SLOTB=8192;
constexpr int LDS_K=0, LDS_V=NSLOT*SLOTB, LDS_WS=2*NSLOT*SLOTB, LDS_OST=LDS_WS+NW*64*4, LDS_BIAS=LDS_OST+NW*4096, TBLN=2304, TPAD=256, LDS_BYTES=LDS_BIAS+TBLN*4;
constexpr float C2=0.125f*1.4426950408889634f;
__device__ __forceinline__ void glds16(const void*gsrc,unsigned lds_dst){unsigned keep;
  asm volatile("s_mov_b32 %0, m0\n\ts_mov_b32 m0, %2\n\ts_nop 0\n\tglobal_load_lds_dwordx4 %1, off\n\ts_mov_b32 m0, %0":"=&s"(keep):"v"(gsrc),"s"(lds_dst):"memory");}
__device__ __forceinline__ float max3f(float a,float b,float c){float r;asm("v_max3_f32 %0, %1, %2, %3":"=v"(r):"v"(a),"v"(b),"v"(c));return r;}
__device__ __forceinline__ float max2f(float a,float b){float r;asm("v_max_f32_e32 %0, %1, %2":"=v"(r):"v"(a),"v"(b));return r;}
__device__ __forceinline__ float fadd_s(float a,float b){float r;asm("v_add_f32_e32 %0, %1, %2":"=v"(r):"v"(a),"v"(b));return r;}
__device__ __forceinline__ float fsub_s(float a,float b){float r;asm("v_sub_f32_e32 %0, %1, %2":"=v"(r):"v"(a),"v"(b));return r;}
typedef float f32x2_t __attribute__((ext_vector_type(2))); typedef __bf16 bf16x2_t __attribute__((ext_vector_type(2)));
__device__ __forceinline__ unsigned cvtpk_s(float lo,float hi){f32x2_t v={lo,hi};bf16x2_t b=__builtin_convertvector(v,bf16x2_t);return __builtin_bit_cast(unsigned,b);}
#define WAIT_BAR(N) asm volatile("s_waitcnt vmcnt(" #N ") lgkmcnt(0)\n\ts_barrier":::"memory")

__device__ __forceinline__ void qkt(f32x16&p0,f32x16&p1,const char*Kslot,const bf16x8*qr,const f32x16&negm,int r32,int hi){
  const char*kb=Kslot+hi*1024+r32*16;
  #pragma unroll
  for(int d0=0;d0<4;++d0){
    const bf16x8 b0=*reinterpret_cast<const bf16x8*>(kb+d0*2048);
    const bf16x8 b1=*reinterpret_cast<const bf16x8*>(kb+d0*2048+512);
    if(d0==0){p0=__builtin_amdgcn_mfma_f32_32x32x16_bf16(b0,qr[0],negm,0,0,0);p1=__builtin_amdgcn_mfma_f32_32x32x16_bf16(b1,qr[0],negm,0,0,0);}
    else{p0=__builtin_amdgcn_mfma_f32_32x32x16_bf16(b0,qr[d0],p0,0,0,0);p1=__builtin_amdgcn_mfma_f32_32x32x16_bf16(b1,qr[d0],p1,0,0,0);}}
}
typedef __attribute__((address_space(3))) const char* lds_cptr;
typedef __attribute__((address_space(3))) const float* lds_fptr;
typedef short v4i16_t __attribute__((ext_vector_type(4)));
__device__ __forceinline__ void kload8(bf16x8*kf,lds_cptr kp){
  kf[0]=*(const __attribute__((address_space(3))) bf16x8*)(kp);      kf[1]=*(const __attribute__((address_space(3))) bf16x8*)(kp+512);
  kf[2]=*(const __attribute__((address_space(3))) bf16x8*)(kp+2048); kf[3]=*(const __attribute__((address_space(3))) bf16x8*)(kp+2560);
  kf[4]=*(const __attribute__((address_space(3))) bf16x8*)(kp+4096); kf[5]=*(const __attribute__((address_space(3))) bf16x8*)(kp+4608);
  kf[6]=*(const __attribute__((address_space(3))) bf16x8*)(kp+6144); kf[7]=*(const __attribute__((address_space(3))) bf16x8*)(kp+6656);
}
__device__ __forceinline__ void kload2(bf16x8*kf,lds_cptr kp,int j){ kf[2*j]=*(const __attribute__((address_space(3))) bf16x8*)(kp+j*2048); kf[2*j+1]=*(const __attribute__((address_space(3))) bf16x8*)(kp+j*2048+512); }
__device__ __forceinline__ s16x4 vtr(lds_cptr p){ return __builtin_bit_cast(s16x4,__builtin_amdgcn_ds_read_tr16_b64_v4i16((__attribute__((address_space(3))) v4i16_t*)p)); }
__device__ __forceinline__ float rowmax(const f32x16&p0,const f32x16&p1){
  float a=max3f(p0[0],p0[1],p1[0]),b=max3f(p0[2],p0[3],p1[1]);a=max3f(a,p1[2],p1[3]);
  #pragma unroll
  for(int r=4;r<16;r+=4){a=max3f(a,p0[r],p0[r+1]);b=max3f(b,p0[r+2],p0[r+3]);a=max3f(a,p1[r],p1[r+1]);b=max3f(b,p1[r+2],p1[r+3]);}
  const float m=max2f(a,b);
  auto rr=__builtin_amdgcn_permlane32_swap(__float_as_uint(m),__float_as_uint(m),false,false);
  return max2f(__uint_as_float(rr[0]),__uint_as_float(rr[1]));
}
__device__ __forceinline__ void pv(f32x16*o,int vb,bf16x8 pa0,bf16x8 pa1,bf16x8 pa2,bf16x8 pa3){
  #pragma unroll
  for(int d0=0;d0<2;++d0){s16x4 lo[4],hi[4];
    #pragma unroll
    for(int ks=0;ks<4;++ks){
      asm volatile("ds_read_b64_tr_b16 %0,%1 offset:%c2":"=&v"(lo[ks]):"v"(vb),"i"(d0*4096+ks*1024):"memory");
      asm volatile("ds_read_b64_tr_b16 %0,%1 offset:%c2":"=&v"(hi[ks]):"v"(vb),"i"(d0*4096+ks*1024+512):"memory");}
    asm volatile("s_waitcnt lgkmcnt(0)":::"memory");SBAR();
    #define PK(k) (bf16x8){lo[k][0],lo[k][1],lo[k][2],lo[k][3],hi[k][0],hi[k][1],hi[k][2],hi[k][3]}
    o[d0]=__builtin_amdgcn_mfma_f32_32x32x16_bf16(pa0,PK(0),o[d0],0,0,0);
    o[d0]=__builtin_amdgcn_mfma_f32_32x32x16_bf16(pa1,PK(1),o[d0],0,0,0);
    o[d0]=__builtin_amdgcn_mfma_f32_32x32x16_bf16(pa2,PK(2),o[d0],0,0,0);
    o[d0]=__builtin_amdgcn_mfma_f32_32x32x16_bf16(pa3,PK(3),o[d0],0,0,0);
    #undef PK
  }
}
__device__ __forceinline__ int t5_bucket(int d){
  if(d<16)return d;
  int b=16; b+=(d>=22); b+=(d>=30); b+=(d>=40); b+=(d>=54); b+=(d>=73); b+=(d>=99); b+=(d>=134); b+=(d>=182); b+=(d>=246); b+=(d>=332); b+=(d>=450); b+=(d>=609); b+=(d>=825); b+=(d>=1117); b+=(d>=1513);
  return b;
}
struct AttnJob {
  const bf16* Q; const bf16* K; const bf16* V; bf16* O; float* LSE;
  int q0, t0, NT;
  int W, PM;
  const float* biasg;
};
#ifndef ATTN_STORE16
#define ATTN_STORE16(p,v) (*(u32x4*)(p)=(v))
#endif
template<int THRL,bool WIN,int R> __device__ __forceinline__ void attn_unit(const AttnJob&J,char*shm){
  int tid_=threadIdx.x; asm volatile("":"+v"(tid_));
  const int tid=tid_,lane=tid&63,r32=lane&31,hi=lane>>5; const int wid=__builtin_amdgcn_readfirstlane(tid>>6);
  constexpr long pin=(long)R*9728; constexpr long pout=WIN?(long)R*512:1024; constexpr long plse=(long)R*8;
  const int q0=J.q0;
  const bf16*Qw=J.Q+(long)(q0+wid*QBLK)*pin;
  const bf16*Kh=J.K+(long)J.t0*KVBLK*pin,*Vh=J.V+(long)J.t0*KVBLK*pin;
  const unsigned lds0=(unsigned)(uintptr_t)shm;
  float*wsf=(float*)(shm+LDS_WS)+wid*64;
  const bf16*ksrc=Kh+(long)lane*pin+wid*8;
  const bf16*vsrc=Vh+(long)(16*(wid&3)+(lane>>2))*pin+(wid>>2)*32+(lane&3)*8;
  const unsigned kdst=lds0+LDS_K+wid*1024, vdst=lds0+LDS_V+wid*1024;
  #define DMA_K(t,slot) glds16(ksrc+(long)(t)*KVBLK*pin,(unsigned)__builtin_amdgcn_readfirstlane(kdst+(slot)))
  #define DMA_V(t,slot) glds16(vsrc+(long)(t)*KVBLK*pin,(unsigned)__builtin_amdgcn_readfirstlane(vdst+(slot)))
  const int vb0=(int)(lds0+LDS_V)+((lane>>4)&1)*32+(lane&3)*8+(4*hi+((lane&15)>>2))*64;
  const char*Kbase=shm+LDS_K; bf16x8 kf[8];
  const lds_cptr shm3=(lds_cptr)shm; const lds_cptr kp0=shm3+LDS_K+hi*1024+r32*16; const lds_cptr vp0=shm3+LDS_V+((lane>>4)&1)*32+(lane&3)*8+(4*hi+((lane&15)>>2))*64;
  const int NT=J.NT-J.t0;
  { const int npieces=(2*TPAD+q0-KVBLK*J.t0+255)>>8;
    for(int pc=wid;pc<npieces;pc+=NW) glds16((const char*)J.biasg+pc*1024+lane*16,(unsigned)__builtin_amdgcn_readfirstlane(lds0+LDS_BIAS+pc*1024)); }
  const lds_fptr Tb3=(lds_fptr)(shm3+LDS_BIAS);
  DMA_K(0,0);DMA_V(0,0);DMA_K(1,SLOTB);
  bf16x8 qr[4];
  #pragma unroll
  for(int d0=0;d0<4;++d0)qr[d0]=*reinterpret_cast<const bf16x8*>(&Qw[(long)r32*pin+d0*16+hi*8]);
  float mhat=0.f,l_reg=0.f;f32x16 o[2];o[0]=f32x16{};o[1]=f32x16{};f32x16 negm=f32x16{};asm volatile("":"+v"(negm));
  const int qrel=wid*QBLK+r32;
  const int tbase=TPAD+qrel-4*hi+64*(NT-4);
  #define BIAS(P0,P1,t) do{ const lds_fptr tp_=Tb3+(tbase-64*(t)); \
    _Pragma("unroll") for(int r=0;r<16;++r){ P0[r]+=tp_[-((r&3)+8*(r>>2))]; P1[r]+=tp_[-32-((r&3)+8*(r>>2))]; } }while(0)
  #define CMASK(P0,P1,t) do{ if(WIN){ wmask(P0,P1,64*((t)-(NT-4)),qrel,hi,J.W,J.PM); } else { int jb_=(t)-(NT-4); if(jb_>=0)cmask(P0,P1,jb_,qrel,hi); } }while(0)
  bool resc=false;
  #define START(P0,P1) do{ const float rm=rowmax(P0,P1); resc=false; \
    { const float dl=WIN?max2f(rm,-1000.f):rm; mhat=fadd_s(mhat,dl); \
      _Pragma("unroll") for(int r=0;r<16;++r){P0[r]=fsub_s(P0[r],dl);P1[r]=fsub_s(P1[r],dl);} \
      _Pragma("unroll") for(int r=0;r<16;++r)negm[r]=-mhat; asm volatile("":"+v"(negm)); } \
    _Pragma("unroll") for(int r=0;r<16;++r)P0[r]=__builtin_amdgcn_exp2f(P0[r]); }while(0)
  #define RESC() do{ if(resc){ asm volatile("s_waitcnt lgkmcnt(0)":::"memory"); \
      _Pragma("unroll") for(int d_=0;d_<2;++d_) _Pragma("unroll") for(int r=0;r<16;++r)o[d_][r]*=wsf[crow(r,hi)]; } }while(0)
  f32x16 pA0,pA1,pB0,pB1;
  int sl_prev=0,sl_cur=0,sl_next=SLOTB;
  #define ROT() do{sl_prev=sl_cur;sl_cur=sl_next;sl_next=(sl_next==(NSLOT-1)*SLOTB)?0:sl_next+SLOTB;}while(0)
  DMA_K(2,2*SLOTB);
  WAIT_BAR(3);
  qkt(pA0,pA1,Kbase,qr,negm,r32,hi);asm volatile("s_nop 15\n\ts_nop 7":"+v"(pA0),"+v"(pA1));BIAS(pA0,pA1,0);CMASK(pA0,pA1,0);
  START(pA0,pA1);
  _Pragma("unroll") for(int r=0;r<16;++r)pA1[r]=__builtin_amdgcn_exp2f(pA1[r]);
  WAIT_BAR(0);
  DMA_K(3,0);DMA_V(1,SLOTB);
  ROT();
  kload8(kf,kp0+sl_cur);
  WAIT_BAR(2);
  s16x4 vlo[8],vhi[8]; u32x4 pw0,pw1,pw2,pw3;
  #define PKW(P,B) cvtpk_s(P[B],P[B+1])
  #define PAF(k) __builtin_bit_cast(bf16x8,pw##k)
  #define VFR(i) (bf16x8){vlo[i][0],vlo[i][1],vlo[i][2],vlo[i][3],vhi[i][0],vhi[i][1],vhi[i][2],vhi[i][3]}
  #define PIN(x) asm volatile("":"+v"(x))
  #define MX3(a,b,c) __builtin_fmaxf(__builtin_fmaxf((a),(b)),(c))
  #define GAPA(MF,A0,A1,A2,A3,W0,W1,PW) do{ MF; sacc+=A0; sacc+=A1; sacc+=A2; sacc+=A3; PIN(sacc); W0; W1; PIN(PW); SBAR(); }while(0)
  #define EX(v) __builtin_amdgcn_exp2f(v)
  #define BLD(bb,OFF) do{ bb[0]=tq_[-(OFF)]; bb[1]=tq_[-(OFF)-1]; bb[2]=tq_[-(OFF)-2]; bb[3]=tq_[-(OFF)-3]; }while(0)
  #define GAPB(MF,X,B,bc,bn,NOFF) do{ if((NOFF)>=0){BLD(bn,NOFF);} MF; X[B]=EX(X[B]+bc[0]); X[B+1]=EX(X[B+1]+bc[1]); X[B+2]=EX(X[B+2]+bc[2]); X[B+3]=EX(X[B+3]+bc[3]); PIN(X); SBAR(); }while(0)
  #define VRD(i) do{ vlo[i]=vtr(vp_+(((i)>>2)*4096+((i)&3)*1024)); vhi[i]=vtr(vp_+(((i)>>2)*4096+((i)&3)*1024+512)); }while(0)
  #define KRD(G,j) do{ if(G){ kload2(kf,kp0+sl_next,j); SBAR(); } }while(0)
  #define STEP(C0,C1,P0,P1,t,GK,GV,GL,MSK) do{ SBAR(); \
    const lds_cptr vp_=vp0+sl_prev; \
    VRD(0); SBAR(); float sacc=(P0[0]+P0[1]); \
    GAPA(C0=__builtin_amdgcn_mfma_f32_32x32x16_bf16(kf[0],qr[0],negm,0,0,0), P0[2],P0[3],P0[4],P0[5],     pw0[0]=PKW(P0,0), pw0[1]=PKW(P0,2), pw0); \
    VRD(4); SBAR(); GAPA(C1=__builtin_amdgcn_mfma_f32_32x32x16_bf16(kf[1],qr[0],negm,0,0,0), P0[6],P0[7],P0[8],P0[9],     pw0[2]=PKW(P0,4), pw0[3]=PKW(P0,6), pw0); \
    VRD(1); SBAR(); GAPA(C0=__builtin_amdgcn_mfma_f32_32x32x16_bf16(kf[2],qr[1],C0,0,0,0),   P0[10],P0[11],P0[12],P0[13], pw1[0]=PKW(P0,8), pw1[1]=PKW(P0,10), pw1); \
    VRD(5); SBAR(); GAPA(C1=__builtin_amdgcn_mfma_f32_32x32x16_bf16(kf[3],qr[1],C1,0,0,0),   P0[14],P0[15],P1[0],P1[1],   pw1[2]=PKW(P0,12),pw1[3]=PKW(P0,14), pw1); \
    VRD(2); SBAR(); GAPA(C0=__builtin_amdgcn_mfma_f32_32x32x16_bf16(kf[4],qr[2],C0,0,0,0),   P1[2],P1[3],P1[4],P1[5],     pw2[0]=PKW(P1,0), pw2[1]=PKW(P1,2), pw2); \
    VRD(6); SBAR(); GAPA(C1=__builtin_amdgcn_mfma_f32_32x32x16_bf16(kf[5],qr[2],C1,0,0,0),   P1[6],P1[7],P1[8],P1[9],     pw2[2]=PKW(P1,4), pw2[3]=PKW(P1,6), pw2); \
    VRD(3); SBAR(); GAPA(C0=__builtin_amdgcn_mfma_f32_32x32x16_bf16(kf[6],qr[3],C0,0,0,0),   P1[10],P1[11],P1[12],P1[13], pw3[0]=PKW(P1,8), pw3[1]=PKW(P1,10), pw3); \
    VRD(7); SBAR(); GAPA(C1=__builtin_amdgcn_mfma_f32_32x32x16_bf16(kf[7],qr[3],C1,0,0,0),   P1[14],P1[15],0.f,0.f,       pw3[2]=PKW(P1,12),pw3[3]=PKW(P1,14), pw3); \
    l_reg+=sacc; \
    if(GK){DMA_K((t)+3,sl_cur);} if(GV){DMA_V((t)+1,sl_next);} \
    if(MSK){CMASK(C0,C1,t);} \
    const lds_fptr tq_=Tb3+(tbase-64*(t)); float bA_[4],bB_[4]; BLD(bA_,0); \
    { float a=MX3(C0[0],C0[1],C1[0]),b=MX3(C0[2],C0[3],C1[1]); a=MX3(a,C1[2],C1[3]); \
      _Pragma("unroll") for(int r=4;r<16;r+=4){a=MX3(a,C0[r],C0[r+1]);b=MX3(b,C0[r+2],C0[r+3]);a=MX3(a,C1[r],C1[r+1]);b=MX3(b,C1[r+2],C1[r+3]);} \
      float rm=__builtin_fmaxf(a,b); { auto rr=__builtin_amdgcn_permlane32_swap(__float_as_uint(rm),__float_as_uint(rm),false,false); rm=__builtin_fmaxf(__uint_as_float(rr[0]),__uint_as_float(rr[1])); } \
      resc=false; \
      if(__builtin_expect(__any(rm>(float)THRL),0)){ const float dl=__builtin_fmaxf(rm,0.f); mhat+=dl; \
        _Pragma("unroll") for(int r=0;r<16;++r){C0[r]-=dl;C1[r]-=dl;} \
        _Pragma("unroll") for(int r=0;r<16;++r)negm[r]=-mhat; asm volatile("":"+v"(negm)); \
        const float f=__builtin_amdgcn_exp2f(-dl); l_reg*=f; if(hi==0)wsf[r32]=f; resc=true; } } \
    SBAR(); \
    GAPB(o[0]=__builtin_amdgcn_mfma_f32_32x32x16_bf16(PAF(0),VFR(0),o[0],0,0,0), C0,0, bA_,bB_,8); \
    GAPB(o[1]=__builtin_amdgcn_mfma_f32_32x32x16_bf16(PAF(0),VFR(4),o[1],0,0,0), C0,4, bB_,bA_,16); \
    KRD(GL,0); GAPB(o[0]=__builtin_amdgcn_mfma_f32_32x32x16_bf16(PAF(1),VFR(1),o[0],0,0,0), C0,8, bA_,bB_,24); \
    KRD(GL,1); GAPB(o[1]=__builtin_amdgcn_mfma_f32_32x32x16_bf16(PAF(1),VFR(5),o[1],0,0,0), C0,12, bB_,bA_,32); \
    KRD(GL,2); GAPB(o[0]=__builtin_amdgcn_mfma_f32_32x32x16_bf16(PAF(2),VFR(2),o[0],0,0,0), C1,0, bA_,bB_,40); \
    KRD(GL,3); GAPB(o[1]=__builtin_amdgcn_mfma_f32_32x32x16_bf16(PAF(2),VFR(6),o[1],0,0,0), C1,4, bB_,bA_,48); \
    GAPB(o[0]=__builtin_amdgcn_mfma_f32_32x32x16_bf16(PAF(3),VFR(3),o[0],0,0,0), C1,8, bA_,bB_,56); \
    GAPB(o[1]=__builtin_amdgcn_mfma_f32_32x32x16_bf16(PAF(3),VFR(7),o[1],0,0,0), C1,12, bB_,bA_,-1); \
    }while(0)
  int t=1;
  if constexpr(!WIN){
  for(;t+5<NT;t+=2){
    STEP(pB0,pB1,pA0,pA1,t,true,true,true,false);     WAIT_BAR(2); RESC(); ROT();
    STEP(pA0,pA1,pB0,pB1,t+1,true,true,true,false);   WAIT_BAR(2); RESC(); ROT();
  }
  }
  #define ENDW(tt) do{ if((tt)+3<NT){WAIT_BAR(2);} else if((tt)+2<NT){WAIT_BAR(1);} else {WAIT_BAR(0);} }while(0)
  for(;t+1<NT;t+=2){
    STEP(pB0,pB1,pA0,pA1,t,(t+3<NT),(t+1<NT),(t+1<NT),true);       ENDW(t);   RESC(); ROT();
    STEP(pA0,pA1,pB0,pB1,t+1,(t+4<NT),(t+2<NT),(t+2<NT),true);     ENDW(t+1); RESC(); ROT();
  }
  STEP(pB0,pB1,pA0,pA1,NT-1,false,false,false,true); RESC();
  { float sacc=pB0[0]+pB0[1]; _Pragma("unroll") for(int r=2;r<16;++r)sacc+=pB0[r]; _Pragma("unroll") for(int r=0;r<16;++r)sacc+=pB1[r]; l_reg+=sacc;
    pw0=(u32x4){PKW(pB0,0),PKW(pB0,2),PKW(pB0,4),PKW(pB0,6)};pw1=(u32x4){PKW(pB0,8),PKW(pB0,10),PKW(pB0,12),PKW(pB0,14)};pw2=(u32x4){PKW(pB1,0),PKW(pB1,2),PKW(pB1,4),PKW(pB1,6)};pw3=(u32x4){PKW(pB1,8),PKW(pB1,10),PKW(pB1,12),PKW(pB1,14)};
    SBAR(); pv(o,vb0+sl_cur,PAF(0),PAF(1),PAF(2),PAF(3)); }
  #undef PKW
  #undef PAF
  #undef VFR
  #undef PIN
  #undef MX3
  #undef GAPA
  #undef GAPB
  #undef BLD
  #undef EX
  #undef VRD
  #undef KRD
  #undef STEP
  #undef ENDW
  {auto rr=__builtin_amdgcn_permlane32_swap(__float_as_uint(l_reg),__float_as_uint(l_reg),false,false);l_reg=__uint_as_float(rr[0])+__uint_as_float(rr[1]);}
  if(J.LSE!=nullptr && hi==0) J.LSE[(long)(q0+qrel)*plse]=(mhat+__builtin_amdgcn_logf(l_reg))*0.6931471805599453f;
  if(hi==0)wsf[32+r32]=l_reg;asm volatile("s_waitcnt lgkmcnt(0)":::"memory");
  float rli[16];
  #pragma unroll
  for(int r=0;r<16;++r)rli[r]=__builtin_amdgcn_rcpf(wsf[32+crow(r,hi)]);
  bf16*Ow=J.O+(long)(q0+wid*QBLK)*pout;
  { bf16*stg=(bf16*)(shm+LDS_OST)+wid*2048;
    #pragma unroll
    for(int r=0;r<16;++r){const int orow=crow(r,hi);
      #pragma unroll
      for(int d0=0;d0<2;++d0)stg[orow*64+d0*32+r32]=__float2bfloat16(o[d0][r]*rli[r]);}
    asm volatile("s_waitcnt lgkmcnt(0)":::"memory");
    #pragma unroll
    for(int i=0;i<4;++i){const int row=i*8+(lane>>3),ch=lane&7; const u32x4 v=*(const u32x4*)(stg+row*64+ch*8); ATTN_STORE16(Ow+(long)row*pout+ch*8,v);} }
  asm volatile("s_waitcnt lgkmcnt(0)\n\ts_barrier":::"memory");
  #undef DMA_K
  #undef DMA_V
  #undef CMASK
  #undef BIAS
  #undef START
  #undef RESC
  #undef ROT
}
constexpr int ATTN_LDS_BYTES=LDS_BYTES;
#undef SBAR
#undef WAIT_BAR
}
constexpr int NWAVES = 8;
constexpr int NB = 8, SEQ = 2048, DM = 1024, DEPTH = 4, M = NB * SEQ;
constexpr int INW = 9728;
constexpr int COL_QA = 0, COL_KA = 1536, COL_VA = 3072, COL_QB = 4608, COL_KB = 5632, COL_VB = 6656, COL_GA = 7680, COL_GB = 8704;
constexpr int NEXP = 16384, PHEADS = 8, TOPK = 16, PQW = 2048;
constexpr float NORM_EPS = 1e-6f, SUBLN_EPS = 1e-5f;
constexpr size_t MiB = 1u << 20;
constexpr size_t WS_CTL = 0, CTL_ZERO_BYTES = 1 * MiB;
constexpr size_t WS_MOD = 1 * MiB;
constexpr size_t WS_SUBK = 2 * MiB;
constexpr size_t WS_BIAS = 3 * MiB;
constexpr size_t WS_SU = 3 * MiB + 512 * 1024, WS_SV = 3 * MiB + 768 * 1024;
constexpr size_t WS_WPA = 4 * MiB;
constexpr size_t WS_WPB = 8 * MiB;
constexpr size_t WS_WO = 16 * MiB;
constexpr size_t WS_WQ = 24 * MiB;
constexpr size_t WS_WIN = 40 * MiB;
constexpr size_t WS_U = 116 * MiB;
constexpr size_t WS_V = 244 * MiB;
constexpr size_t WS_H = 372 * MiB;
constexpr size_t WS_PROJ = 404 * MiB;
constexpr size_t WS_PQ = WS_PROJ;
constexpr size_t WS_IDS = WS_PROJ + 64 * MiB;
constexpr size_t WS_GATES = WS_PROJ + 72 * MiB;
constexpr size_t WS_ODIFF = 708 * MiB;
constexpr size_t WS_TMP = WS_ODIFF;
constexpr size_t WS_ODIL = 772 * MiB;
constexpr size_t WS_MERGED = WS_ODIL;
constexpr size_t WS_LSE = 820 * MiB;
constexpr size_t WS_OA = 822 * MiB;
constexpr size_t WS_OB = 838 * MiB;
constexpr size_t WS_END = 870 * MiB;
constexpr size_t WS_DBG = 880 * MiB;
constexpr int CW_BAR = 4096;
constexpr int RING_BYTES = 131072;
constexpr int LDSCTL_OFF = RING_BYTES, MISC_OFF = LDSCTL_OFF + 320;
constexpr int LDS_BYTES = 147456;
constexpr int PH_PRO_A = 0, PH_PRO_B = 1, PH_LAYER0 = 2, PH_PER_LAYER = 9, NPHASE = PH_LAYER0 + DEPTH * PH_PER_LAYER;

#define GAS __attribute__((address_space(1)))
#define LAS __attribute__((address_space(3)))
typedef unsigned short bf16;
typedef unsigned v4u __attribute__((ext_vector_type(4)));
typedef unsigned v2u __attribute__((ext_vector_type(2)));
typedef float f32x4 __attribute__((ext_vector_type(4)));
typedef float f32x16 __attribute__((ext_vector_type(16)));
typedef short bf16x8 __attribute__((ext_vector_type(8)));
typedef __bf16 bf16x2_t __attribute__((ext_vector_type(2)));
typedef GAS unsigned gu32;
#define RLX_AGENT __ATOMIC_RELAXED, __HIP_MEMORY_SCOPE_AGENT
#define LDS_WAIT() asm volatile("s_waitcnt lgkmcnt(0)" ::: "memory")
#define VM_WAIT() asm volatile("s_waitcnt vmcnt(0)" ::: "memory")
__device__ __forceinline__ unsigned f2bf(float f) { unsigned u = __builtin_bit_cast(unsigned, f); return (u + 0x7fffu + ((u >> 16) & 1u)) >> 16; }
__device__ __forceinline__ unsigned pk2(float lo, float hi) { return f2bf(lo) | (f2bf(hi) << 16); }
__device__ __forceinline__ float bflo(unsigned w) { return __uint_as_float(w << 16); }
__device__ __forceinline__ float bfhi(unsigned w) { return __uint_as_float(w & 0xffff0000u); }
#define XB_TMO      128
#define XB_XCNT(j)  (256  + 64 * (j))
#define XB_XSUB(j)  (1280 + 64 * (j))
#define XB_XGEN(j)  (2304 + 64 * (j))
#define XB_TOP      3328
#define XB_TOPGEN   3392
#define XCD_BAR_WORDS 3456
#define XB_SPIN_CAP (1u << 18)

__device__ __forceinline__ unsigned xb_ld(unsigned* p)              { return __hip_atomic_load(p, __ATOMIC_RELAXED, __HIP_MEMORY_SCOPE_AGENT); }
__device__ __forceinline__ unsigned xb_add(unsigned* p, unsigned v) { return __hip_atomic_fetch_add(p, v, __ATOMIC_RELAXED, __HIP_MEMORY_SCOPE_AGENT); }
__device__ __forceinline__ unsigned xb_xcc_id() { return (unsigned)__builtin_amdgcn_s_getreg((3 << 11) | 20) & 0xFu; }
#define XB_SPIN(cond, bar) do { unsigned _sp = 0; while (cond) { __builtin_amdgcn_s_sleep(1); \
    if ((++_sp & 255u) == 0u) { if (xb_ld(&(bar)[XB_TMO])) break; if (_sp > XB_SPIN_CAP) { atomicAdd(&(bar)[XB_TMO], 1u); break; } } } } while (0)

struct XcdBarrier {
    unsigned* bar; unsigned x;
    volatile LAS unsigned* st;
};

__device__ __forceinline__ XcdBarrier xcd_barrier_post(unsigned* bar, volatile LAS unsigned* st) {
    XcdBarrier b; b.bar = bar; b.x = xb_xcc_id(); b.st = st;
    if (threadIdx.x == 0) (void)xb_add(&bar[XB_XCNT(b.x)], 1u);
    return b;
}
__device__ __forceinline__ void xcd_barrier_complete(unsigned* bar, unsigned x, unsigned& nloc, unsigned& nx) {
    const unsigned G = gridDim.x * gridDim.y * gridDim.z;
    unsigned sum, cnt, mine, sp = 0u;
    for (;;) {
        sum = 0u; cnt = 0u; mine = 0u;
#pragma unroll
        for (unsigned j = 0; j < 16; ++j) { const unsigned c = xb_ld(&bar[XB_XCNT(j)]); sum += c; cnt += (c > 0u) ? 1u : 0u; mine = (j == x) ? c : mine; }
        if (sum == G) break;
        __builtin_amdgcn_s_sleep(1);
        if ((++sp & 255u) == 0u) { if (xb_ld(&bar[XB_TMO])) break; if (sp > XB_SPIN_CAP) { atomicAdd(&bar[XB_TMO], 1u); break; } }
    }
    nloc = mine > 0u ? mine : 1u; nx = cnt > 0u ? cnt : 1u;
}

__device__ __forceinline__ void xcd_barrier(const XcdBarrier& b) {
    asm volatile("s_waitcnt vmcnt(0)" ::: "memory");
    __syncthreads();
    if (threadIdx.x == 0) {
        unsigned* bar = b.bar;
        __builtin_amdgcn_s_waitcnt(0);
        unsigned nloc = b.st[0], nx = b.st[1];
        if (nloc == 0u) { xcd_barrier_complete(bar, b.x, nloc, nx); b.st[0] = nloc; b.st[1] = nx; }
        const unsigned old = xb_add(&bar[XB_XSUB(b.x)], 1u);
        const unsigned gen = old / nloc;
        if (old + 1u == (gen + 1u) * nloc) {
            __builtin_amdgcn_fence(__ATOMIC_RELEASE, "agent");
            asm volatile("s_waitcnt vmcnt(0)" ::: "memory");
            const unsigned og = xb_add(&bar[XB_TOP], 1u);
            const unsigned tg = og / nx;
            if (og + 1u == (tg + 1u) * nx) xb_add(&bar[XB_TOPGEN], 1u);
            else XB_SPIN(xb_ld(&bar[XB_TOPGEN]) == tg, bar);
            __builtin_amdgcn_fence(__ATOMIC_ACQUIRE, "agent");
            xb_add(&bar[XB_XGEN(b.x)], 1u);
            asm volatile("s_waitcnt vmcnt(0)" ::: "memory");
        } else {
            XB_SPIN(xb_ld(&bar[XB_XGEN(b.x)]) == gen, bar);
            __builtin_amdgcn_fence(__ATOMIC_ACQUIRE, "agent");
            asm volatile("s_waitcnt vmcnt(0)" ::: "memory");
        }
    }
    __syncthreads();
}
struct Args { const float* in[21]; float* out; unsigned char* ws; int ph_lo, ph_hi; };
struct Frame {
    LAS unsigned char* lds; unsigned char* ldsg;
    int tid, lane, wave, vcu, G;
};
__device__ __forceinline__ float wave_sum(float v) {
#pragma unroll
    for (int o = 1; o < 64; o <<= 1) v += __shfl_xor(v, o);
    return v;
}
__device__ __forceinline__ void p0_transpose_item(const float* W, int K, int N, bf16* WT, LAS float* scr, int item, int lane) {
    const int nblk = N / 32, kb = item / nblk, nb = item % nblk, k0 = 64 * kb, n0 = 32 * nb;
#pragma unroll 8
    for (int i = 0; i < 32; ++i) { const int kk = 2 * i + (lane >> 5); scr[kk * 33 + (lane & 31)] = W[(size_t)(k0 + kk) * N + n0 + (lane & 31)]; }
    LDS_WAIT(); asm volatile("" ::: "memory");
    const int c = lane & 7;
#pragma unroll
    for (int j = 0; j < 4; ++j) { const int n = (lane >> 3) + 8 * j; const LAS float* s = scr + (8 * c) * 33 + n;
        v4u o; o.x = pk2(s[0 * 33], s[1 * 33]); o.y = pk2(s[2 * 33], s[3 * 33]); o.z = pk2(s[4 * 33], s[5 * 33]); o.w = pk2(s[6 * 33], s[7 * 33]);
        *(GAS v4u*)(WT + (size_t)(n0 + n) * K + k0 + 8 * c) = o; }
    LDS_WAIT(); asm volatile("" ::: "memory");
}
__device__ __forceinline__ void cvt_stream(const float* src, bf16* dst, size_t nchunks, size_t gtid, size_t nthreads) {
    for (size_t c = gtid; c < nchunks; c += nthreads) { const f32x4 a = *(const GAS f32x4*)(src + c * 8), b = *(const GAS f32x4*)(src + c * 8 + 4);
        v4u o; o.x = pk2(a.x, a.y); o.y = pk2(a.z, a.w); o.z = pk2(b.x, b.y); o.w = pk2(b.z, b.w); *(GAS v4u*)(dst + c * 8) = o; }
}
__device__ __forceinline__ void prologue_a(Frame& F, const Args& A) {
    const int gw = F.vcu * NWAVES + F.wave, NGW = F.G * NWAVES;
    { LAS float* scr = (LAS float*)(F.lds + F.wave * 16384);
      constexpr int I_IN = (DM / 64) * (INW / 32), I_PA = (512 / 64) * (DM / 32), I_PB = (DM / 64) * (DM / 32), I_O = I_PB, I_Q = (DM / 64) * (PQW / 32);
      constexpr int PER_L = I_IN + I_PA + I_PB + I_O + I_Q, NITEMS = DEPTH * PER_L;
      for (int it = gw; it < NITEMS; it += NGW) {
          const int l = it / PER_L; int r = it % PER_L;
          if (r < I_IN) { p0_transpose_item(A.in[6] + (size_t)l * DM * INW, DM, INW, (bf16*)(A.ws + WS_WIN) + (size_t)l * INW * DM, scr, r, F.lane); continue; } r -= I_IN;
          if (r < I_PA) { p0_transpose_item(A.in[7] + (size_t)l * 512 * DM, 512, DM, (bf16*)(A.ws + WS_WPA) + (size_t)l * DM * 512, scr, r, F.lane); continue; } r -= I_PA;
          if (r < I_PB) { p0_transpose_item(A.in[8] + (size_t)l * DM * DM, DM, DM, (bf16*)(A.ws + WS_WPB) + (size_t)l * DM * DM, scr, r, F.lane); continue; } r -= I_PB;
          if (r < I_O) { p0_transpose_item(A.in[9] + (size_t)l * DM * DM, DM, DM, (bf16*)(A.ws + WS_WO) + (size_t)l * DM * DM, scr, r, F.lane); continue; } r -= I_O;
          p0_transpose_item(A.in[16] + (size_t)l * DM * PQW, DM, PQW, (bf16*)(A.ws + WS_WQ) + (size_t)l * PQW * DM, scr, r, F.lane);
      } }
    { const size_t gtid = (size_t)gw * 64 + F.lane, nthr = (size_t)NGW * 64;
      for (int rr = gw; rr < 2 * DEPTH * NEXP; rr += NGW) { const int tb = rr >= DEPTH * NEXP, row = tb ? rr - DEPTH * NEXP : rr;
          const float* src = (tb ? A.in[19] : A.in[18]) + (size_t)row * DM + 16 * F.lane;
          const f32x4 a0 = *(const GAS f32x4*)src, a1 = *(const GAS f32x4*)(src + 4), a2 = *(const GAS f32x4*)(src + 8), a3 = *(const GAS f32x4*)(src + 12);
          float am = fmaxf(fmaxf(fmaxf(fabsf(a0.x), fabsf(a0.y)), fmaxf(fabsf(a0.z), fabsf(a0.w))), fmaxf(fmaxf(fabsf(a1.x), fabsf(a1.y)), fmaxf(fabsf(a1.z), fabsf(a1.w))));
          am = fmaxf(am, fmaxf(fmaxf(fmaxf(fabsf(a2.x), fabsf(a2.y)), fmaxf(fabsf(a2.z), fabsf(a2.w))), fmaxf(fmaxf(fabsf(a3.x), fabsf(a3.y)), fmaxf(fabsf(a3.z), fabsf(a3.w)))));
#pragma unroll
          for (int o = 1; o < 64; o <<= 1) am = fmaxf(am, __shfl_xor(am, o));
          const float sc = am > 0.f ? 256.0f / am : 1.0f;
          int w0 = 0, w1 = 0, w2 = 0, w3 = 0;
          w0 = __builtin_amdgcn_cvt_pk_fp8_f32(a0.x * sc, a0.y * sc, w0, false); w0 = __builtin_amdgcn_cvt_pk_fp8_f32(a0.z * sc, a0.w * sc, w0, true);
          w1 = __builtin_amdgcn_cvt_pk_fp8_f32(a1.x * sc, a1.y * sc, w1, false); w1 = __builtin_amdgcn_cvt_pk_fp8_f32(a1.z * sc, a1.w * sc, w1, true);
          w2 = __builtin_amdgcn_cvt_pk_fp8_f32(a2.x * sc, a2.y * sc, w2, false); w2 = __builtin_amdgcn_cvt_pk_fp8_f32(a2.z * sc, a2.w * sc, w2, true);
          w3 = __builtin_amdgcn_cvt_pk_fp8_f32(a3.x * sc, a3.y * sc, w3, false); w3 = __builtin_amdgcn_cvt_pk_fp8_f32(a3.z * sc, a3.w * sc, w3, true);
          *(GAS v4u*)((unsigned char*)(A.ws + (tb ? WS_V : WS_U)) + (size_t)row * DM + 16 * F.lane) = (v4u){(unsigned)w0, (unsigned)w1, (unsigned)w2, (unsigned)w3};
          if (F.lane == 0) ((float*)(A.ws + (tb ? WS_SV : WS_SU)))[row] = am > 0.f ? am * (1.0f / 256.0f) : 1.0f; }
      cvt_stream(A.in[17], (bf16*)(A.ws + WS_SUBK), (size_t)DEPTH * 2 * 128 * 128 / 8, gtid, nthr);
      float* BT = (float*)(A.ws + WS_BIAS);
      for (size_t i = gtid; i < (size_t)32 * attn_body::TBLN; i += nthr) { const int hd = (int)(i / attn_body::TBLN), d = (int)(i % attn_body::TBLN) - attn_body::TPAD;
          const int st = (hd < 8 || hd >= 24) ? 1 : (hd < 16 ? 4 : 8); float v = 0.f;
          if (d >= 0) { int dist = d * st; dist = dist > 2047 ? 2047 : dist; v = A.in[15][attn_body::t5_bucket(dist) * 32 + hd] * 1.4426950408889634f; }
          BT[i] = v; } }
    __syncthreads();
    { LAS float* sil = (LAS float*)F.lds;
      LAS float* red = (LAS float*)(F.lds + 32768);
      for (int i = F.tid; i < NB * DM; i += NWAVES * 64) { const float v = A.in[1][i]; sil[i] = v / (1.0f + __expf(-v)); }
      __syncthreads();
      constexpr int NJB = 6 * DM / 64;
      for (int u = F.vcu; u < DEPTH * NJB; u += F.G) {
          const int l = u / NJB, jb = u % NJB, j = jb * 64 + F.lane;
          const float* Wp = A.in[2] + (size_t)l * DM * 6 * DM + (size_t)(F.wave * 128) * 6 * DM + j;
          float acc[8];
#pragma unroll
          for (int b = 0; b < 8; ++b) acc[b] = 0.f;
#pragma unroll 8
          for (int k = 0; k < 128; ++k) { const float w = Wp[(size_t)k * 6 * DM];
#pragma unroll
              for (int b = 0; b < 8; ++b) acc[b] += sil[b * DM + F.wave * 128 + k] * w; }
#pragma unroll
          for (int b = 0; b < 8; ++b) red[(F.wave * 8 + b) * 64 + F.lane] = acc[b];
          __syncthreads();
          { const int b = F.tid >> 6, ln = F.tid & 63; float s = 0.f;
#pragma unroll
            for (int w = 0; w < 8; ++w) s += red[(w * 8 + b) * 64 + ln];
            ((float*)(A.ws + WS_MOD))[((size_t)l * NB + b) * 6 * DM + jb * 64 + ln] = s + A.in[3][(size_t)l * 6 * DM + jb * 64 + ln]; }
          __syncthreads();
      } }
}
__device__ __forceinline__ void norm_row_store(const f32x4 (&v)[4], const float* g, const float* sc, const float* sh, bf16* orow, int lane) {
    float s = 0.f;
#pragma unroll
    for (int j = 0; j < 4; ++j) s += (v[j].x * v[j].x + v[j].y * v[j].y) + (v[j].z * v[j].z + v[j].w * v[j].w);
    const float r = 1.0f / sqrtf(wave_sum(s) * (1.0f / DM) + NORM_EPS);
    GAS v2u* o8 = (GAS v2u*)orow + lane;
#pragma unroll
    for (int j = 0; j < 4; ++j) { const int c = 4 * lane + 256 * j; const f32x4 gg = *(const f32x4*)(g + c), cc = *(const f32x4*)(sc + c), hh = *(const f32x4*)(sh + c);
        const f32x4 y = v[j] * r * gg * (cc + 1.0f) + hh; v2u w; w.x = pk2(y.x, y.y); w.y = pk2(y.z, y.w); o8[64 * j] = w; }
}
__device__ __forceinline__ void prologue_b(Frame& F, const Args& A) {
    const int gw = F.vcu * NWAVES + F.wave, NGW = F.G * NWAVES;
    const float* mod = (const float*)(A.ws + WS_MOD);
    for (int m = gw; m < M; m += NGW) { const int b = m / SEQ;
        const GAS f32x4* xr = (const GAS f32x4*)(A.in[0] + (size_t)m * DM) + F.lane; GAS f32x4* xo = (GAS f32x4*)(A.out + (size_t)m * DM) + F.lane;
        f32x4 v[4];
#pragma unroll
        for (int j = 0; j < 4; ++j) { v[j] = xr[64 * j]; xo[64 * j] = v[j]; }
        norm_row_store(v, A.in[4], mod + (size_t)b * 6 * DM + 1 * DM, mod + (size_t)b * 6 * DM + 0 * DM, (bf16*)(A.ws + WS_H) + (size_t)m * DM, F.lane); }
}
__device__ __forceinline__ void norm2_phase(Frame& F, const Args& A, int l) {
    const int gw = F.vcu * NWAVES + F.wave, NGW = F.G * NWAVES;
    const float* mod = (const float*)(A.ws + WS_MOD) + (size_t)l * NB * 6 * DM;
    for (int m = gw; m < M; m += NGW) { const int b = m / SEQ;
        const GAS f32x4* xr = (const GAS f32x4*)(A.out + (size_t)m * DM) + F.lane;
        f32x4 v[4];
#pragma unroll
        for (int j = 0; j < 4; ++j) v[j] = xr[64 * j];
        norm_row_store(v, A.in[5] + (size_t)l * DM, mod + (size_t)b * 6 * DM + 4 * DM, mod + (size_t)b * 6 * DM + 3 * DM, (bf16*)(A.ws + WS_H) + (size_t)m * DM, F.lane); }
}
__device__ __forceinline__ void attn_phase_all(Frame& F, const Args& A) {
    using namespace attn_body;
    const __hip_bfloat16* P = (const __hip_bfloat16*)(A.ws + WS_PROJ);
    __hip_bfloat16* OD = (__hip_bfloat16*)(A.ws + WS_ODIFF); __hip_bfloat16* OG = (__hip_bfloat16*)(A.ws + WS_ODIL); float* LS = (float*)(A.ws + WS_LSE);
    const float* BT = (const float*)(A.ws + WS_BIAS);
    constexpr int NUNITS = 14 * 256;
    for (int L = F.vcu; L < NUNITS; L += F.G) {
        const int round = L >> 8, c = L & 255;
        AttnJob J;
        if (round < 8) {
            const int b = c >> 5, h = (c >> 2) & 7, sub = (c >> 1) & 1, vh = c & 1; const int qb = (round & 1) ? (round >> 1) : 7 - (round >> 1);
            const size_t rb = (size_t)b * SEQ;
            J.Q = P + rb * INW + COL_QB + h * 128 + sub * 64; J.K = P + rb * INW + COL_KB + h * 128 + sub * 64; J.V = P + rb * INW + COL_VB + h * 128 + vh * 64;
            J.O = OD + (size_t)sub * M * DM + rb * DM + h * 128 + vh * 64; J.LSE = nullptr;
            J.q0 = 256 * qb; J.t0 = 0; J.NT = 4 * qb + 4; J.W = 0; J.PM = 0; J.biasg = BT + (size_t)(24 + h) * attn_body::TBLN;
            attn_unit<8, false, 1>(J, (char*)F.ldsg);
        } else {
            int g, b, h, m, qb, r, W, PM;
            const int u = 2 * c + (round & 1);
            if (round < 10) { g = 0; b = u >> 6; h = (u >> 3) & 7; m = 0; qb = u & 7; r = 1; W = 128; PM = 0; }
            else if (round < 12) { g = 1; b = u >> 6; h = (u >> 3) & 7; m = (u >> 1) & 3; qb = u & 1; r = 4; W = 128; PM = 0; }
            else { g = 2; b = u >> 6; h = (u >> 3) & 7; m = u & 7; qb = 0; r = 8; W = 256; PM = 1; }
            const size_t rb = (size_t)b * SEQ + m;
            J.Q = P + rb * INW + COL_QA + g * 512 + h * 64; J.K = P + rb * INW + COL_KA + g * 512 + h * 64; J.V = P + rb * INW + COL_VA + g * 512 + h * 64;
            J.O = OG + (size_t)g * M * 512 + rb * 512 + h * 64; J.LSE = LS + (size_t)g * M * 8 + rb * 8 + h;
            J.q0 = 256 * qb; J.t0 = (qb > 0) ? 4 * qb - 2 : 0; J.NT = 4 * qb + 4; J.W = W; J.PM = PM; J.biasg = BT + (size_t)(8 * g + h) * attn_body::TBLN;
            if (g == 0) attn_unit<8, true, 1>(J, (char*)F.ldsg); else if (g == 1) attn_unit<8, true, 4>(J, (char*)F.ldsg); else attn_unit<8, true, 8>(J, (char*)F.ldsg);
        }
    }
}
__device__ __forceinline__ void combine_phase(Frame& F, const Args& A, int l) {
    const int gw = F.vcu * NWAVES + F.wave, NGW = F.G * NWAVES, lane = F.lane;
    const float lam_init = 0.8f - 0.6f * expf(-0.3f * (float)l);
    const float d1 = wave_sum(A.in[10][l * 64 + lane] * A.in[11][l * 64 + lane]), d2 = wave_sum(A.in[12][l * 64 + lane] * A.in[13][l * 64 + lane]);
    const float lam = expf(d1) - expf(d2) + lam_init;
    const bf16* OG = (const bf16*)(A.ws + WS_ODIL); const float* LS = (const float*)(A.ws + WS_LSE); const bf16* OD = (const bf16*)(A.ws + WS_ODIFF);
    bf16* OA = (bf16*)(A.ws + WS_OA); bf16* OB = (bf16*)(A.ws + WS_OB);
    const int hd = lane >> 3, c8 = (lane & 7) * 8, c16 = (lane & 7) * 16;
    float sg[16];
#pragma unroll
    for (int i = 0; i < 16; ++i) sg[i] = A.in[14][l * 128 + c16 + i] * (1.0f - lam_init);
    for (int t = gw; t < M; t += NGW) {
        { const float l0 = LS[(size_t)t * 8 + hd], l1 = LS[(size_t)M * 8 + (size_t)t * 8 + hd], l2 = LS[(size_t)2 * M * 8 + (size_t)t * 8 + hd];
          const float mx = fmaxf(l0, fmaxf(l1, l2)); float w0 = __expf(l0 - mx), w1 = __expf(l1 - mx), w2 = __expf(l2 - mx); const float inv = 1.0f / (w0 + w1 + w2); w0 *= inv; w1 *= inv; w2 *= inv;
          const v4u a = *(const GAS v4u*)(OG + (size_t)t * 512 + hd * 64 + c8), b = *(const GAS v4u*)(OG + (size_t)M * 512 + (size_t)t * 512 + hd * 64 + c8), c = *(const GAS v4u*)(OG + (size_t)2 * M * 512 + (size_t)t * 512 + hd * 64 + c8);
          v4u o;
          o.x = pk2(w0 * bflo(a.x) + w1 * bflo(b.x) + w2 * bflo(c.x), w0 * bfhi(a.x) + w1 * bfhi(b.x) + w2 * bfhi(c.x));
          o.y = pk2(w0 * bflo(a.y) + w1 * bflo(b.y) + w2 * bflo(c.y), w0 * bfhi(a.y) + w1 * bfhi(b.y) + w2 * bfhi(c.y));
          o.z = pk2(w0 * bflo(a.z) + w1 * bflo(b.z) + w2 * bflo(c.z), w0 * bfhi(a.z) + w1 * bfhi(b.z) + w2 * bfhi(c.z));
          o.w = pk2(w0 * bflo(a.w) + w1 * bflo(b.w) + w2 * bflo(c.w), w0 * bfhi(a.w) + w1 * bfhi(b.w) + w2 * bfhi(c.w));
          *(GAS v4u*)(OA + (size_t)t * 512 + hd * 64 + c8) = o; }
        { const bf16* p0 = OD + (size_t)t * DM + hd * 128 + c16; const bf16* p1 = OD + (size_t)M * DM + (size_t)t * DM + hd * 128 + c16;
          const v4u a0 = *(const GAS v4u*)p0, a1 = *(const GAS v4u*)(p0 + 8), b0 = *(const GAS v4u*)p1, b1 = *(const GAS v4u*)(p1 + 8);
          float o[16];
          o[0] = bflo(a0.x) - lam * bflo(b0.x); o[1] = bfhi(a0.x) - lam * bfhi(b0.x); o[2] = bflo(a0.y) - lam * bflo(b0.y); o[3] = bfhi(a0.y) - lam * bfhi(b0.y);
          o[4] = bflo(a0.z) - lam * bflo(b0.z); o[5] = bfhi(a0.z) - lam * bfhi(b0.z); o[6] = bflo(a0.w) - lam * bflo(b0.w); o[7] = bfhi(a0.w) - lam * bfhi(b0.w);
          o[8] = bflo(a1.x) - lam * bflo(b1.x); o[9] = bfhi(a1.x) - lam * bfhi(b1.x); o[10] = bflo(a1.y) - lam * bflo(b1.y); o[11] = bfhi(a1.y) - lam * bfhi(b1.y);
          o[12] = bflo(a1.z) - lam * bflo(b1.z); o[13] = bfhi(a1.z) - lam * bfhi(b1.z); o[14] = bflo(a1.w) - lam * bflo(b1.w); o[15] = bfhi(a1.w) - lam * bfhi(b1.w);
          float ss = 0.f;
#pragma unroll
          for (int i = 0; i < 16; ++i) ss += o[i] * o[i];
          ss += __shfl_xor(ss, 1); ss += __shfl_xor(ss, 2); ss += __shfl_xor(ss, 4);
          const float r = 1.0f / sqrtf(ss * (1.0f / 128.0f) + SUBLN_EPS);
          v4u w0, w1;
          w0.x = pk2(o[0] * r * sg[0], o[1] * r * sg[1]); w0.y = pk2(o[2] * r * sg[2], o[3] * r * sg[3]); w0.z = pk2(o[4] * r * sg[4], o[5] * r * sg[5]); w0.w = pk2(o[6] * r * sg[6], o[7] * r * sg[7]);
          w1.x = pk2(o[8] * r * sg[8], o[9] * r * sg[9]); w1.y = pk2(o[10] * r * sg[10], o[11] * r * sg[11]); w1.z = pk2(o[12] * r * sg[12], o[13] * r * sg[13]); w1.w = pk2(o[14] * r * sg[14], o[15] * r * sg[15]);
          bf16* q = OB + (size_t)t * DM + hd * 128 + c16; *(GAS v4u*)q = w0; *(GAS v4u*)(q + 8) = w1; }
    }
}
#define CE_DESC(a, b) do { const float _hi = fmaxf(a, b), _lo = fminf(a, b); a = _hi; b = _lo; } while (0)
__device__ __forceinline__ void sort16_desc(float (&v)[16]) {
#pragma unroll
    for (int k = 2; k <= 16; k <<= 1)
#pragma unroll
        for (int j = k >> 1; j > 0; j >>= 1)
#pragma unroll
            for (int i = 0; i < 16; ++i) { const int p = i ^ j; if (p > i) { if ((i & k) == 0) { CE_DESC(v[i], v[p]); } else { CE_DESC(v[p], v[i]); } } }
}
__device__ __forceinline__ void merge16_desc(float (&a)[16], const float (&b)[16]) {
#pragma unroll
    for (int i = 0; i < 16; ++i) a[i] = fmaxf(a[i], b[15 - i]);
#pragma unroll
    for (int j = 8; j > 0; j >>= 1)
#pragma unroll
        for (int i = 0; i < 16; ++i) { const int p = i ^ j; if (p > i) CE_DESC(a[i], a[p]); }
}
__device__ __forceinline__ float pack_idx(float v, unsigned idx, unsigned mask) { return __uint_as_float((__float_as_uint(v) & ~mask) | idx); }
__device__ __forceinline__ void topk_phase(Frame& F, const Args& A, int l) {
    const int gw = F.vcu * NWAVES + F.wave, NGW = F.G * NWAVES, lane = F.lane, r32 = lane & 31, hi = lane >> 5;
    { const bf16* SK = (const bf16*)(A.ws + WS_SUBK) + (size_t)l * 2 * 128 * 128;
      for (int c = F.tid; c < 256 * 16; c += NWAVES * 64) { const int row = c >> 4, ch = c & 15; const v4u v = *(const GAS v4u*)(SK + row * 128 + ch * 8); *(LAS v4u*)(F.lds + row * 272 + ch * 16) = v; }
      __syncthreads(); }
    LAS unsigned char* sk = F.lds;
    LAS unsigned char* ibuf = F.lds + 69632 + F.wave * 2048 + lane * 32;
    const bf16* PQ = (const bf16*)(A.ws + WS_PQ);
    int* IDS = (int*)(A.ws + WS_IDS); float* GT = (float*)(A.ws + WS_GATES);
    for (int unit = gw; unit < (M / 32) * PHEADS; unit += NGW) {
        const int tile = unit >> 3, h = unit & 7, tok = tile * 32 + r32;
        const bf16* qrow = PQ + (size_t)tok * PQW + h * 256;
        float X[64], Y[64];
#pragma unroll
        for (int p = 0; p < 2; ++p) {
            bf16x8 qf[8];
#pragma unroll
            for (int k0 = 0; k0 < 8; ++k0) qf[k0] = *(const GAS bf16x8*)(qrow + p * 128 + k0 * 16 + hi * 8);
#pragma unroll
            for (int kb = 0; kb < 4; ++kb) { f32x16 acc = f32x16{};
                const LAS unsigned char* ap = sk + (p * 128 + kb * 32 + r32) * 272 + hi * 16;
#pragma unroll
                for (int k0 = 0; k0 < 8; ++k0) { const bf16x8 a = *(const LAS bf16x8*)(ap + k0 * 32); acc = __builtin_amdgcn_mfma_f32_32x32x16_bf16(a, qf[k0], acc, 0, 0, 0); }
#pragma unroll
                for (int r = 0; r < 16; ++r) { if (p == 0) X[kb * 16 + r] = acc[r]; else Y[kb * 16 + r] = acc[r]; } }
        }
#pragma unroll
        for (int i = 0; i < 64; ++i) { auto rr = __builtin_amdgcn_permlane32_swap(__float_as_uint(X[i]), __float_as_uint(Y[i]), false, false); X[i] = __uint_as_float(rr[0]); Y[i] = __uint_as_float(rr[1]); }
#pragma unroll
        for (int i = 0; i < 64; ++i) { const unsigned key = 32u * (i >> 4) + (unsigned)((i & 3) + 8 * ((i & 15) >> 2)); X[i] = pack_idx(X[i], key, 127u); Y[i] = pack_idx(Y[i], key + 4u, 127u); }
        float top[16];
        { float g0[16], g1[16];
#pragma unroll
          for (int i = 0; i < 16; ++i) { top[i] = X[i]; g0[i] = X[16 + i]; }
          sort16_desc(top); sort16_desc(g0); merge16_desc(top, g0);
#pragma unroll
          for (int i = 0; i < 16; ++i) { g0[i] = X[32 + i]; g1[i] = X[48 + i]; }
          sort16_desc(g0); sort16_desc(g1); merge16_desc(g0, g1); merge16_desc(top, g0);
#pragma unroll
          for (int i = 0; i < 16; ++i) { g0[i] = Y[i]; g1[i] = Y[16 + i]; }
          sort16_desc(g0); sort16_desc(g1); merge16_desc(g0, g1); merge16_desc(top, g0);
#pragma unroll
          for (int i = 0; i < 16; ++i) { g0[i] = Y[32 + i]; g1[i] = Y[48 + i]; }
          sort16_desc(g0); sort16_desc(g1); merge16_desc(g0, g1); merge16_desc(top, g0); }
        float a[16], b[16];
#pragma unroll
        for (int i = 0; i < 16; ++i) { auto rr = __builtin_amdgcn_permlane32_swap(__float_as_uint(top[i]), __float_as_uint(top[i]), false, false); a[i] = __uint_as_float(rr[0]); b[i] = __uint_as_float(rr[1]); }
        { unsigned wa[4], wb[4];
#pragma unroll
          for (int q = 0; q < 4; ++q) { wa[q] = (__float_as_uint(a[4 * q]) & 127u) | ((__float_as_uint(a[4 * q + 1]) & 127u) << 8) | ((__float_as_uint(a[4 * q + 2]) & 127u) << 16) | ((__float_as_uint(a[4 * q + 3]) & 127u) << 24);
                                         wb[q] = (__float_as_uint(b[4 * q]) & 127u) | ((__float_as_uint(b[4 * q + 1]) & 127u) << 8) | ((__float_as_uint(b[4 * q + 2]) & 127u) << 16) | ((__float_as_uint(b[4 * q + 3]) & 127u) << 24); }
          *(LAS v4u*)ibuf = (v4u){wa[0], wa[1], wa[2], wa[3]}; *(LAS v4u*)(ibuf + 16) = (v4u){wb[0], wb[1], wb[2], wb[3]}; }
        float c0[16], c1[16], c2[16], c3[16];
        { const float NEGI = -INFINITY;
#define CAND(i, j) pack_idx(a[i] + b[j], (unsigned)(((i) << 4) | (j)), 255u)
          c0[0] = CAND(0, 0); c0[1] = CAND(0, 1); c0[2] = CAND(0, 2); c0[3] = CAND(0, 3); c0[4] = CAND(0, 4); c0[5] = CAND(0, 5); c0[6] = CAND(0, 6); c0[7] = CAND(0, 7);
          c0[8] = CAND(0, 8); c0[9] = CAND(0, 9); c0[10] = CAND(0, 10); c0[11] = CAND(0, 11); c0[12] = CAND(0, 12); c0[13] = CAND(0, 13); c0[14] = CAND(0, 14); c0[15] = CAND(0, 15);
          c1[0] = CAND(1, 0); c1[1] = CAND(1, 1); c1[2] = CAND(1, 2); c1[3] = CAND(1, 3); c1[4] = CAND(1, 4); c1[5] = CAND(1, 5); c1[6] = CAND(1, 6); c1[7] = CAND(1, 7);
          c1[8] = CAND(2, 0); c1[9] = CAND(2, 1); c1[10] = CAND(2, 2); c1[11] = CAND(2, 3); c1[12] = CAND(2, 4); c1[13] = CAND(3, 0); c1[14] = CAND(3, 1); c1[15] = CAND(3, 2);
          c2[0] = CAND(3, 3); c2[1] = CAND(4, 0); c2[2] = CAND(4, 1); c2[3] = CAND(4, 2); c2[4] = CAND(5, 0); c2[5] = CAND(5, 1); c2[6] = CAND(6, 0); c2[7] = CAND(6, 1);
          c2[8] = CAND(7, 0); c2[9] = CAND(7, 1); c2[10] = CAND(8, 0); c2[11] = CAND(9, 0); c2[12] = CAND(10, 0); c2[13] = CAND(11, 0); c2[14] = CAND(12, 0); c2[15] = CAND(13, 0);
          c3[0] = CAND(14, 0); c3[1] = CAND(15, 0);
#pragma unroll
          for (int i = 2; i < 16; ++i) c3[i] = NEGI;
#undef CAND
        }
        sort16_desc(c0); sort16_desc(c1); sort16_desc(c2); sort16_desc(c3); merge16_desc(c0, c1); merge16_desc(c2, c3); merge16_desc(c0, c2);
        float e[16], z = 0.f;
#pragma unroll
        for (int i = 0; i < 16; ++i) { e[i] = __expf(c0[i] - c0[0]); z += e[i]; }
        const float iz = 1.0f / z;
        LDS_WAIT();
#pragma unroll
        for (int k = 0; k < 8; ++k) { const float cv = hi ? c0[k + 8] : c0[k]; const float ev = hi ? e[k + 8] : e[k]; const unsigned bits = __float_as_uint(cv);
            const unsigned ia = ibuf[(bits >> 4) & 15u], ib = ibuf[16 + (bits & 15u)];
            const size_t o = (size_t)tok * 128 + h * 16 + k + 8 * hi; IDS[o] = (int)(ia * 128u + ib); GT[o] = ev * iz; }
        LDS_WAIT();
    }
}
typedef float f32x2 __attribute__((ext_vector_type(2)));
__device__ __forceinline__ float dpp_sum16(float x) {
    x += __int_as_float(__builtin_amdgcn_update_dpp(0, __float_as_int(x), 0xB1, 0xf, 0xf, true));
    x += __int_as_float(__builtin_amdgcn_update_dpp(0, __float_as_int(x), 0x4E, 0xf, 0xf, true));
    x += __int_as_float(__builtin_amdgcn_update_dpp(0, __float_as_int(x), 0x141, 0xf, 0xf, true));
    x += __int_as_float(__builtin_amdgcn_update_dpp(0, __float_as_int(x), 0x140, 0xf, 0xf, true));
    return x;
}
__device__ __forceinline__ float gelu_tanh(float x) {
    const float y = 0.7978845608028654f * (x + 0.044715f * x * x * x);
    const float e = __builtin_amdgcn_exp2f(2.0f * 1.4426950408889634f * y);
    const float th = 1.0f - 2.0f * __builtin_amdgcn_rcpf(e + 1.0f);
    return 0.5f * x * (1.0f + th);
}
__device__ __forceinline__ void dot16_fp8(const v4u u, const f32x2 (&h)[8], f32x2& acc) {
    const unsigned w0 = u.x, w1 = u.y, w2 = u.z, w3 = u.w;
    acc = __builtin_elementwise_fma(__builtin_amdgcn_cvt_pk_f32_fp8((int)w0, false), h[0], acc); acc = __builtin_elementwise_fma(__builtin_amdgcn_cvt_pk_f32_fp8((int)w0, true), h[1], acc);
    acc = __builtin_elementwise_fma(__builtin_amdgcn_cvt_pk_f32_fp8((int)w1, false), h[2], acc); acc = __builtin_elementwise_fma(__builtin_amdgcn_cvt_pk_f32_fp8((int)w1, true), h[3], acc);
    acc = __builtin_elementwise_fma(__builtin_amdgcn_cvt_pk_f32_fp8((int)w2, false), h[4], acc); acc = __builtin_elementwise_fma(__builtin_amdgcn_cvt_pk_f32_fp8((int)w2, true), h[5], acc);
    acc = __builtin_elementwise_fma(__builtin_amdgcn_cvt_pk_f32_fp8((int)w3, false), h[6], acc); acc = __builtin_elementwise_fma(__builtin_amdgcn_cvt_pk_f32_fp8((int)w3, true), h[7], acc);
}
__device__ __forceinline__ void axpy16_fp8(const v4u v, const float s, f32x2 (&o)[8]) {
    const unsigned w0 = v.x, w1 = v.y, w2 = v.z, w3 = v.w; const f32x2 ss = {s, s};
    o[0] = __builtin_elementwise_fma(__builtin_amdgcn_cvt_pk_f32_fp8((int)w0, false), ss, o[0]); o[1] = __builtin_elementwise_fma(__builtin_amdgcn_cvt_pk_f32_fp8((int)w0, true), ss, o[1]);
    o[2] = __builtin_elementwise_fma(__builtin_amdgcn_cvt_pk_f32_fp8((int)w1, false), ss, o[2]); o[3] = __builtin_elementwise_fma(__builtin_amdgcn_cvt_pk_f32_fp8((int)w1, true), ss, o[3]);
    o[4] = __builtin_elementwise_fma(__builtin_amdgcn_cvt_pk_f32_fp8((int)w2, false), ss, o[4]); o[5] = __builtin_elementwise_fma(__builtin_amdgcn_cvt_pk_f32_fp8((int)w2, true), ss, o[5]);
    o[6] = __builtin_elementwise_fma(__builtin_amdgcn_cvt_pk_f32_fp8((int)w3, false), ss, o[6]); o[7] = __builtin_elementwise_fma(__builtin_amdgcn_cvt_pk_f32_fp8((int)w3, true), ss, o[7]);
}
__device__ __forceinline__ void peer_phase(Frame& F, const Args& A, int l) {
    const int gw = F.vcu * NWAVES + F.wave, NGW = F.G * NWAVES, lane = F.lane, g = lane >> 4, j = lane & 15;
    const unsigned char* U8 = (const unsigned char*)(A.ws + WS_U) + (size_t)l * NEXP * DM; const unsigned char* V8 = (const unsigned char*)(A.ws + WS_V) + (size_t)l * NEXP * DM;
    const float* SU = (const float*)(A.ws + WS_SU) + (size_t)l * NEXP; const float* SV = (const float*)(A.ws + WS_SV) + (size_t)l * NEXP;
    const bf16* H = (const bf16*)(A.ws + WS_H); bf16* Hn = (bf16*)(A.ws + WS_H);
    const int* IDS = (const int*)(A.ws + WS_IDS); const float* GT = (const float*)(A.ws + WS_GATES);
    const float* mod = (const float*)(A.ws + WS_MOD);
    LAS unsigned* sids = (LAS unsigned*)(F.lds + F.wave * 6144);
    LAS float* ssu = (LAS float*)(F.lds + F.wave * 6144 + 2048);
    LAS float* sgs = (LAS float*)(F.lds + F.wave * 6144 + 4096);
    constexpr int PCH = 8;
    for (int bt = gw; bt < M / 4; bt += NGW) {
#pragma unroll 1
        for (int tq = 0; tq < 4; ++tq) {
            const int tk = bt * 4 + tq;
            unsigned v0 = ((unsigned)IDS[(size_t)tk * 128 + lane] << 7) | (unsigned)lane, v1 = ((unsigned)IDS[(size_t)tk * 128 + 64 + lane] << 7) | (unsigned)(64 + lane);
#pragma unroll
            for (int k = 2; k <= 128; k <<= 1)
#pragma unroll
                for (int jj = k >> 1; jj > 0; jj >>= 1) {
                    if (jj == 64) { const unsigned lo = min(v0, v1), hi = max(v0, v1); v0 = lo; v1 = hi; }
                    else { const unsigned p0 = (unsigned)__shfl_xor((int)v0, jj), p1 = (unsigned)__shfl_xor((int)v1, jj);
                        const bool lower = (lane & jj) == 0; const bool up0 = ((lane & k) == 0) || (k == 128), up1 = (((lane + 64) & k) == 0) || (k == 128);
                        v0 = (lower == up0) ? min(v0, p0) : max(v0, p0); v1 = (lower == up1) ? min(v1, p1) : max(v1, p1); }
                }
            const unsigned id0 = v0 >> 7, id1 = v1 >> 7;
            sids[tq * 128 + lane] = id0; sids[tq * 128 + 64 + lane] = id1;
            ssu[tq * 128 + lane] = SU[id0]; ssu[tq * 128 + 64 + lane] = SU[id1];
            sgs[tq * 128 + lane] = GT[(size_t)tk * 128 + (v0 & 127u)] * SV[id0]; sgs[tq * 128 + 64 + lane] = GT[(size_t)tk * 128 + (v1 & 127u)] * SV[id1];
        }
        LDS_WAIT();
        const int tk = bt * 4 + g; const int b = tk / SEQ;
        const LAS unsigned* myid = sids + g * 128; const LAS float* mysu = ssu + g * 128; LAS float* mygs = sgs + g * 128;
        v4u buf[PCH][4];
        {   f32x2 hf[4][8];
#pragma unroll
            for (int q = 0; q < 4; ++q) { const v4u a = *(const GAS v4u*)(H + (size_t)tk * DM + 256 * q + 16 * j), c = *(const GAS v4u*)(H + (size_t)tk * DM + 256 * q + 16 * j + 8);
                hf[q][0] = (f32x2){bflo(a.x), bfhi(a.x)}; hf[q][1] = (f32x2){bflo(a.y), bfhi(a.y)}; hf[q][2] = (f32x2){bflo(a.z), bfhi(a.z)}; hf[q][3] = (f32x2){bflo(a.w), bfhi(a.w)};
                hf[q][4] = (f32x2){bflo(c.x), bfhi(c.x)}; hf[q][5] = (f32x2){bflo(c.y), bfhi(c.y)}; hf[q][6] = (f32x2){bflo(c.z), bfhi(c.z)}; hf[q][7] = (f32x2){bflo(c.w), bfhi(c.w)}; }
#pragma unroll
            for (int c = 0; c < PCH; ++c) { const unsigned char* ur = U8 + (size_t)myid[c] * DM + 16 * j;
#pragma unroll
                for (int q = 0; q < 4; ++q) buf[c][q] = *(const GAS v4u*)(ur + 256 * q); }
#define PEER_USTEP(E0, MORE) do { _Pragma("unroll") for (int c = 0; c < PCH; ++c) { f32x2 acc = {0.f, 0.f}; \
                    _Pragma("unroll") for (int q = 0; q < 4; ++q) dot16_fp8(buf[c][q], hf[q], acc); \
                    __builtin_amdgcn_sched_barrier(0); \
                    if (MORE) { const unsigned char* ur = U8 + (size_t)myid[(E0) + PCH + c] * DM + 16 * j; \
                        _Pragma("unroll") for (int q = 0; q < 4; ++q) buf[c][q] = *(const GAS v4u*)(ur + 256 * q); } \
                    __builtin_amdgcn_sched_barrier(0); \
                    const float d = dpp_sum16(acc.x + acc.y) * mysu[(E0) + c]; \
                    mygs[(E0) + c] = mygs[(E0) + c] * gelu_tanh(d); } } while (0)
#pragma unroll 1
            for (int e0 = 0; e0 < 128 - PCH; e0 += PCH) PEER_USTEP(e0, true);
            PEER_USTEP(128 - PCH, false);
#undef PEER_USTEP
        }
        LDS_WAIT();
        f32x2 outv[4][8];
#pragma unroll
        for (int q = 0; q < 4; ++q)
#pragma unroll
            for (int i = 0; i < 8; ++i) outv[q][i] = (f32x2){0.f, 0.f};
#pragma unroll
        for (int c = 0; c < PCH; ++c) { const unsigned char* vr = V8 + (size_t)myid[c] * DM + 16 * j;
#pragma unroll
            for (int q = 0; q < 4; ++q) buf[c][q] = *(const GAS v4u*)(vr + 256 * q); }
#define PEER_VSTEP(E0, MORE) do { _Pragma("unroll") for (int c = 0; c < PCH; ++c) { const float s = mygs[(E0) + c]; \
                _Pragma("unroll") for (int q = 0; q < 4; ++q) axpy16_fp8(buf[c][q], s, outv[q]); \
                __builtin_amdgcn_sched_barrier(0); \
                if (MORE) { const unsigned char* vr = V8 + (size_t)myid[(E0) + PCH + c] * DM + 16 * j; \
                    _Pragma("unroll") for (int q = 0; q < 4; ++q) buf[c][q] = *(const GAS v4u*)(vr + 256 * q); } \
                __builtin_amdgcn_sched_barrier(0); } } while (0)
#pragma unroll 1
        for (int e0 = 0; e0 < 128 - PCH; e0 += PCH) PEER_VSTEP(e0, true);
        PEER_VSTEP(128 - PCH, false);
#undef PEER_VSTEP
        int jx = j; asm volatile("" : "+v"(jx));
        float* xr = A.out + (size_t)tk * DM; const float* g2 = mod + ((size_t)l * NB + b) * 6 * DM + 5 * DM;
        float ss = 0.f;
#pragma unroll
        for (int q = 0; q < 4; ++q)
#pragma unroll
            for (int w = 0; w < 4; ++w) { const int c = 256 * q + 16 * jx + 4 * w; const f32x4 x4 = *(const GAS f32x4*)(xr + c), g4 = *(const f32x4*)(g2 + c);
                f32x2 a = outv[q][2 * w], bb = outv[q][2 * w + 1];
                a.x = x4[0] + g4[0] * a.x; a.y = x4[1] + g4[1] * a.y; bb.x = x4[2] + g4[2] * bb.x; bb.y = x4[3] + g4[3] * bb.y;
                ss += (a.x * a.x + a.y * a.y) + (bb.x * bb.x + bb.y * bb.y); outv[q][2 * w] = a; outv[q][2 * w + 1] = bb; }
        const float r = 1.0f / sqrtf(dpp_sum16(ss) * (1.0f / DM) + NORM_EPS);
        if (l == DEPTH - 1) {
            const float* fg = A.in[20];
#pragma unroll
            for (int q = 0; q < 4; ++q)
#pragma unroll
                for (int w = 0; w < 4; ++w) { const int c = 256 * q + 16 * jx + 4 * w; const f32x4 g4 = *(const f32x4*)(fg + c); const f32x2 a = outv[q][2 * w], bb = outv[q][2 * w + 1];
                    *(GAS f32x4*)(xr + c) = (f32x4){a.x * r * g4[0], a.y * r * g4[1], bb.x * r * g4[2], bb.y * r * g4[3]}; }
        } else {
            const float* ng = A.in[4] + (size_t)(l + 1) * DM; const float* mn = mod + ((size_t)(l + 1) * NB + b) * 6 * DM;
#pragma unroll
            for (int q = 0; q < 4; ++q) { unsigned pk[8];
#pragma unroll
                for (int w = 0; w < 4; ++w) { const int c = 256 * q + 16 * jx + 4 * w; const f32x4 g4 = *(const f32x4*)(ng + c), sc4 = *(const f32x4*)(mn + DM + c), sh4 = *(const f32x4*)(mn + c); const f32x2 a = outv[q][2 * w], bb = outv[q][2 * w + 1];
                    *(GAS f32x4*)(xr + c) = (f32x4){a.x, a.y, bb.x, bb.y};
                    pk[2 * w] = pk2(a.x * r * g4[0] * (1.0f + sc4[0]) + sh4[0], a.y * r * g4[1] * (1.0f + sc4[1]) + sh4[1]);
                    pk[2 * w + 1] = pk2(bb.x * r * g4[2] * (1.0f + sc4[2]) + sh4[2], bb.y * r * g4[3] * (1.0f + sc4[3]) + sh4[3]); }
                *(GAS v4u*)(Hn + (size_t)tk * DM + 256 * q + 16 * jx) = (v4u){pk[0], pk[1], pk[2], pk[3]}; *(GAS v4u*)(Hn + (size_t)tk * DM + 256 * q + 16 * jx + 8) = (v4u){pk[4], pk[5], pk[6], pk[7]}; }
        }
        LDS_WAIT();
    }
}
__global__ void __launch_bounds__(NWAVES * 64, 2) hybrid_fwd(Args args) {
    extern __shared__ __attribute__((aligned(16))) unsigned char lds[];
    Frame F;
    F.lds = (LAS unsigned char*)lds; F.ldsg = lds;
    F.tid = threadIdx.x; F.lane = F.tid & 63; F.wave = __builtin_amdgcn_readfirstlane(F.tid >> 6);
    F.G = gridDim.x; { const int bx = blockIdx.x; F.vcu = (F.G % 8 == 0) ? (bx % 8) * (F.G / 8) + bx / 8 : bx; }
    volatile LAS unsigned* MISC = (volatile LAS unsigned*)(F.lds + MISC_OFF);
    for (int u = F.tid; u < (LDS_BYTES - LDSCTL_OFF) / 4; u += NWAVES * 64) ((LAS unsigned*)(F.lds + LDSCTL_OFF))[u] = 0u;
    __syncthreads();
    XcdBarrier bar = xcd_barrier_post((unsigned*)(args.ws + WS_CTL) + CW_BAR, MISC + 8);
    const int lo = args.ph_lo, hi = args.ph_hi;
#ifndef TESTPH
#define TESTPH -1
#endif
#define PHON(k) (TESTPH < 0 || TESTPH == (k))
#define IN(k) (lo <= (k) && (k) < hi)
#ifdef DBG_TIME
#define STAMP(ty) do { if (blockIdx.x == 0 && threadIdx.x == 0) { volatile float* tacc_ = (volatile float*)(args.ws + WS_CTL) + 2048 + 16; volatile unsigned long long* tp_ = (volatile unsigned long long*)(args.ws + WS_CTL + 16384); \
      const unsigned long long tn_ = __builtin_amdgcn_s_memrealtime(); const unsigned long long to_ = *tp_; if (to_ != 0ull) tacc_[ty] = tacc_[ty] + (float)(tn_ - to_); *tp_ = tn_; } } while (0)
#else
#define STAMP(ty) do { } while (0)
#endif
#define SEAM(k) do { if ((k) + 1 < hi) xcd_barrier(bar); STAMP(((k) < PH_LAYER0) ? (k) : 2 + ((k) - PH_LAYER0) % PH_PER_LAYER); } while (0)
#define RELANE() do { int t_ = threadIdx.x; asm volatile("" : "+v"(t_)); F.tid = t_; F.lane = t_ & 63; F.wave = __builtin_amdgcn_readfirstlane(t_ >> 6); } while (0)
    STAMP(15);
    if (PHON(100) && IN(PH_PRO_A)) { RELANE(); prologue_a(F, args); SEAM(PH_PRO_A); }
    if (PHON(101) && IN(PH_PRO_B)) { RELANE(); prologue_b(F, args); SEAM(PH_PRO_B); }
    bf16* Hb = (bf16*)(args.ws + WS_H); bf16* PROJ = (bf16*)(args.ws + WS_PROJ);
#pragma unroll 1
    for (int l = 0; l < DEPTH; ++l) {
        const int base = PH_LAYER0 + l * PH_PER_LAYER;
        if (base + PH_PER_LAYER <= lo || base >= hi) continue;
        if (PHON(0) && IN(base + 0)) {
            pg8::Gemm g{Hb, (const bf16*)(args.ws + WS_WIN) + (size_t)l * INW * DM, M, INW, DM}; pg8::StaticOrder S; S.init(M, INW, F.G, (int)blockIdx.x);
            pg8::EpiProj E{PROJ, INW, attn_body::C2};
            pg8::gemm_phase<pg8::EpiProj, pg8::StaticOrder, true, true>(F.lds, g, S, E);
            SEAM(base + 0);
        }
        if (PHON(1) && IN(base + 1)) { RELANE(); attn_phase_all(F, args); SEAM(base + 1); }
        if (PHON(2) && IN(base + 2)) { RELANE(); combine_phase(F, args, l); SEAM(base + 2); }
        if (PHON(3) && IN(base + 3)) {
            { pg8::Gemm g{(const bf16*)(args.ws + WS_OA), (const bf16*)(args.ws + WS_WPA) + (size_t)l * DM * 512, M, DM, 512}; pg8::StaticOrder S; S.init(M, DM, F.G, (int)blockIdx.x);
              pg8::EpiGateMulF32 E{(float*)(args.ws + WS_TMP), DM, PROJ + COL_GA, INW};
              pg8::gemm_phase<pg8::EpiGateMulF32, pg8::StaticOrder, true, true>(F.lds, g, S, E); }
            VM_WAIT(); __syncthreads();
            { pg8::Gemm g{(const bf16*)(args.ws + WS_OB), (const bf16*)(args.ws + WS_WPB) + (size_t)l * DM * DM, M, DM, DM}; pg8::StaticOrder S; S.init(M, DM, F.G, (int)blockIdx.x);
              pg8::EpiGateAddBf16 E{(bf16*)(args.ws + WS_MERGED), (const float*)(args.ws + WS_TMP), DM, PROJ + COL_GB, INW};
              pg8::gemm_phase<pg8::EpiGateAddBf16, pg8::StaticOrder, true, true>(F.lds, g, S, E); }
            SEAM(base + 3);
        }
        if (PHON(4) && IN(base + 4)) {
            pg8::Gemm g{(const bf16*)(args.ws + WS_MERGED), (const bf16*)(args.ws + WS_WO) + (size_t)l * DM * DM, M, DM, DM}; pg8::StaticOrder S; S.init(M, DM, F.G, (int)blockIdx.x);
            pg8::EpiResid E{args.out, DM, (const float*)(args.ws + WS_MOD) + (size_t)l * NB * 6 * DM + 2 * DM, 6 * DM, SEQ};
            pg8::gemm_phase<pg8::EpiResid, pg8::StaticOrder, true, true>(F.lds, g, S, E);
            SEAM(base + 4);
        }
        if (PHON(5) && IN(base + 5)) { RELANE(); norm2_phase(F, args, l); SEAM(base + 5); }
        if (PHON(6) && IN(base + 6)) {
            pg8::Gemm g{Hb, (const bf16*)(args.ws + WS_WQ) + (size_t)l * PQW * DM, M, PQW, DM}; pg8::StaticOrder S; S.init(M, PQW, F.G, (int)blockIdx.x);
            pg8::EpiBf16<0> E{(bf16*)(args.ws + WS_PQ), PQW, nullptr, 0, 0, 1.f};
            pg8::gemm_phase<pg8::EpiBf16<0>, pg8::StaticOrder, true, true>(F.lds, g, S, E);
            SEAM(base + 6);
        }
        if (PHON(7) && IN(base + 7)) { RELANE(); topk_phase(F, args, l); SEAM(base + 7); }
        if (PHON(8) && IN(base + 8)) { RELANE(); peer_phase(F, args, l); SEAM(base + 8); }
    }
#undef IN
#undef SEAM
}


#ifdef DBG_CHECK
__global__ void __launch_bounds__(256) dbg_k1(Args A, int l) {
    float* dw = (float*)(A.ws + WS_CTL) + 2048;
    const int g = blockIdx.x * 256 + threadIdx.x;
    const bf16* PQ = (const bf16*)(A.ws + WS_PQ); const bf16* SK = (const bf16*)(A.ws + WS_SUBK) + (size_t)l * 2 * 128 * 128;
    const int* IDS = (const int*)(A.ws + WS_IDS); const float* GT = (const float*)(A.ws + WS_GATES);
    if (g < 2048) {
        float* scr = (float*)(A.ws + WS_DBG) + (size_t)g * 512;
        const int tok = g * 8; float miss = 0.f, gerr = 0.f;
        for (int h = 0; h < 8; ++h) {
            for (int p = 0; p < 2; ++p)
                for (int k = 0; k < 128; ++k) { float s = 0.f;
                    for (int d = 0; d < 128; ++d) s += bflo((unsigned)PQ[(size_t)tok * PQW + h * 256 + p * 128 + d]) * bflo((unsigned)SK[(p * 128 + k) * 128 + d]);
                    scr[p * 128 + k] = s; }
            for (int p = 0; p < 2; ++p)
                for (int i = 0; i < 16; ++i) { float best = -INFINITY; int bi = 0;
                    for (int k = 0; k < 128; ++k) { const float v = scr[p * 128 + k]; if (v > best) { best = v; bi = k; } }
                    scr[256 + p * 32 + i] = best; scr[256 + p * 32 + 16 + i] = (float)bi; scr[p * 128 + bi] = -INFINITY; }
            for (int i = 0; i < 16; ++i) for (int j = 0; j < 16; ++j) scr[i * 16 + j] = scr[256 + i] + scr[256 + 32 + j];
            for (int i = 0; i < 16; ++i) { float best = -INFINITY; int bi = 0;
                for (int k = 0; k < 256; ++k) { const float v = scr[k]; if (v > best) { best = v; bi = k; } }
                scr[384 + i] = best; scr[400 + i] = (float)((int)scr[256 + 16 + (bi >> 4)] * 128 + (int)scr[256 + 32 + 16 + (bi & 15)]); scr[bi] = -INFINITY; }
            float z = 0.f; const float b0 = scr[384];
            for (int i = 0; i < 16; ++i) z += __expf(scr[384 + i] - b0);
            for (int i = 0; i < 16; ++i) { const float gi = __expf(scr[384 + i] - b0) / z; const int myid = (int)scr[400 + i]; bool found = false;
                for (int k = 0; k < 16; ++k) { if (IDS[(size_t)tok * 128 + h * 16 + k] == myid) { found = true; gerr += fabsf(GT[(size_t)tok * 128 + h * 16 + k] - gi); } }
                if (!found) miss += 1.f; }
        }
        atomicAdd(dw + 0, miss); atomicAdd(dw + 1, gerr);
    }
    __shared__ float red[256]; __shared__ float sdot;
    if (blockIdx.x < 256) {
        const int tk = blockIdx.x * 64, t = threadIdx.x; const bf16* H = (const bf16*)(A.ws + WS_H) + (size_t)tk * DM;
        const float* Uf = A.in[18] + (size_t)l * NEXP * DM; const float* Vf = A.in[19] + (size_t)l * NEXP * DM;
        float hf[4], on[4] = {0.f, 0.f, 0.f, 0.f};
        for (int i = 0; i < 4; ++i) hf[i] = bflo((unsigned)H[4 * t + i]);
        for (int e = 0; e < 128; ++e) { const int id = IDS[(size_t)tk * 128 + e]; const float gt = GT[(size_t)tk * 128 + e];
            float d = 0.f; for (int i = 0; i < 4; ++i) d += hf[i] * Uf[(size_t)id * DM + 4 * t + i];
            red[t] = d; __syncthreads();
            if (t == 0) { float s = 0.f; for (int i = 0; i < 256; ++i) s += red[i]; sdot = s; }
            __syncthreads();
            const float dd = sdot; const float act = 0.5f * dd * (1.0f + tanhf(0.7978845608028654f * (dd + 0.044715f * dd * dd * dd))); const float s = gt * act;
            for (int i = 0; i < 4; ++i) on[i] += s * Vf[(size_t)id * DM + 4 * t + i];
            __syncthreads(); }
        float* nb = (float*)(A.ws + WS_DBG) + (size_t)(5 << 20) + (size_t)blockIdx.x * DM;
        for (int i = 0; i < 4; ++i) nb[4 * t + i] = on[i];
    }
}
__global__ void __launch_bounds__(256) dbg_k2a(Args A) {
    float* dw = (float*)(A.ws + WS_CTL) + 2048;
    const float* fb = (const float*)(A.ws + WS_DBG) + (size_t)(4 << 20) + (size_t)blockIdx.x * DM; const float* nb = (const float*)(A.ws + WS_DBG) + (size_t)(5 << 20) + (size_t)blockIdx.x * DM;
    float num = 0.f, den = 0.f;
    for (int i = threadIdx.x; i < DM; i += 256) { const float d = fb[i] - nb[i]; num += d * d; den += nb[i] * nb[i]; }
    atomicAdd(dw + 2, num); atomicAdd(dw + 3, den);
}
__global__ void __launch_bounds__(256) dbg_k2b(Args A) {
    const float* dw = (const float*)(A.ws + WS_CTL) + 2048; float Dv;
    if (DBG_CHECK == 1) Dv = dw[0] * (1.0f / 262144.0f); else if (DBG_CHECK == 2) Dv = dw[1] * (1.0f / 262144.0f); else Dv = sqrtf(dw[2] / fmaxf(dw[3], 1e-30f));
    const float al = 1.0f + 100.0f * Dv;
    for (size_t i = (size_t)blockIdx.x * 256 + threadIdx.x; i < (size_t)M * DM; i += (size_t)gridDim.x * 256) A.out[i] *= al;
}
#endif
extern "C" void kernel_launch(void* const* d_in, const int* in_sizes, int n_in, void* d_out, int out_size, void* d_ws, size_t ws_size, hipStream_t stream) {
    static int grid = 0;
    if (grid == 0) {
        if (n_in != 21 || out_size != M * DM || ws_size < WS_END) { fprintf(stderr, "kernel_launch: unexpected problem (n_in %d, out %d, ws %zu)\n", n_in, out_size, ws_size); grid = -1; return; }
        int dev = 0, cus = 0, per_cu = 0;
        if (hipGetDevice(&dev) != hipSuccess || hipDeviceGetAttribute(&cus, hipDeviceAttributeMultiprocessorCount, dev) != hipSuccess) { grid = -1; return; }
        if (hipFuncSetAttribute((const void*)hybrid_fwd, hipFuncAttributeMaxDynamicSharedMemorySize, LDS_BYTES) != hipSuccess) { fprintf(stderr, "kernel_launch: hipFuncSetAttribute failed\n"); grid = -1; return; }
        if (hipOccupancyMaxActiveBlocksPerMultiprocessor(&per_cu, (const void*)hybrid_fwd, NWAVES * 64, LDS_BYTES) != hipSuccess || per_cu < 1) fprintf(stderr, "kernel_launch: occupancy query reports %d\n", per_cu);
        (void)hipGetLastError();
        grid = cus;
    }
    if (grid < 0) return;
    (void)hipMemsetAsync((char*)d_ws + WS_CTL, 0, CTL_ZERO_BYTES, stream);
    Args a{};
    for (int i = 0; i < 21; ++i) a.in[i] = (const float*)d_in[i];
    a.out = (float*)d_out; a.ws = (unsigned char*)d_ws;
#if MK_PER_PHASE
    for (int p = 0; p < NPHASE; ++p) { a.ph_lo = p; a.ph_hi = p + 1;
#ifdef DBG_CHECK
        if (p == PH_LAYER0 + 8) hipLaunchKernelGGL(dbg_k1, dim3(256), dim3(256), 0, stream, a, 0);
#endif
        hipLaunchKernelGGL(hybrid_fwd, dim3(grid), dim3(NWAVES * 64), LDS_BYTES, stream, a); }
#ifdef DBG_CHECK
    hipLaunchKernelGGL(dbg_k2a, dim3(256), dim3(256), 0, stream, a);
    hipLaunchKernelGGL(dbg_k2b, dim3(1024), dim3(256), 0, stream, a);
#endif
#else
    a.ph_lo = 0; a.ph_hi = NPHASE;
    hipLaunchKernelGGL(hybrid_fwd, dim3(grid), dim3(NWAVES * 64), LDS_BYTES, stream, a);
#endif
}
```
